# Optimizing an MI355X kernel written in HIP

```python
import jax, jax.numpy as jnp
from jax import lax
import numpy as np

D_MODEL = 1024
BATCH = 4
SEQ = 4096
DEPTH = 1
DEC_BATCH = 128
DEC_SEQ = 8
PAST_LEN = 8192
PAGE_SIZE = 128

N_HEADS_A = 4
HEAD_DIM_A = 128
WIDTH_A = N_HEADS_A * HEAD_DIM_A
N_HEADS_B = 8
HEAD_DIM_B = 64
WIDTH_B = N_HEADS_B * HEAD_DIM_B
MIX_WIDTH = WIDTH_A + WIDTH_B
CONV_WIDTH = 4
CONV_CH = 3 * WIDTH_A
DELTA_CHUNK = 64
DILATED_PATTERNS = ((128, 1), (512, 4), (2048, 16))
MAX_WINDOW = 2048
Q_BLOCK = 128
D_FF = 4 * D_MODEL
NORM_EPS = 1e-6
SPLIT_SIZES = (3 * WIDTH_A, WIDTH_A, N_HEADS_A, N_HEADS_A, WIDTH_B, WIDTH_B, WIDTH_B)
PROJ_COLS = sum(SPLIT_SIZES)

kernel_name = "hymba_gdn_dilated_swa_step"


def rmsnorm(x, g):
    xf = x.astype(jnp.float32)
    xf = xf * lax.rsqrt(jnp.mean(xf * xf, axis=-1, keepdims=True) + NORM_EPS)
    return (xf * g.astype(jnp.float32)).astype(x.dtype)


def l2norm(x):
    xf = x.astype(jnp.float32)
    return xf * lax.rsqrt(jnp.sum(xf * xf, axis=-1, keepdims=True) + NORM_EPS)


def short_conv(u, buf, w):
    t = u.shape[1]
    up = jnp.concatenate([buf.astype(u.dtype), u], axis=1)
    y = up[:, 0:t] * w[0]
    for i in range(1, CONV_WIDTH):
        y = y + up[:, i:i + t] * w[i]
    return jax.nn.silu(y), up[:, -(CONV_WIDTH - 1):]


def gated_delta_chunked(q, k, v, beta, g, s0):
    b, t, h, _ = q.shape
    dv = v.shape[-1]
    c = DELTA_CHUNK
    n = -(-t // c)
    pad = n * c - t

    def to_chunks(a):
        a = jnp.pad(a.astype(jnp.float32), [(0, 0), (0, pad)] + [(0, 0)] * (a.ndim - 2))
        a = jnp.moveaxis(a, 2, 1)
        return a.reshape(b, h, n, c, *a.shape[3:])

    qc, kc, vc, bc, gc = (to_chunks(a) for a in (q, k, v, beta, g))
    G = jnp.cumsum(gc, axis=-1)
    causal = jnp.tril(jnp.ones((c, c), bool))
    strict = jnp.tril(jnp.ones((c, c), bool), -1)
    diff = G[..., :, None] - G[..., None, :]
    decay = jnp.where(causal, jnp.exp(jnp.where(causal, diff, 0.0)), 0.0)
    kb = kc * bc[..., None]
    vb = vc * bc[..., None]
    lmat = jnp.where(strict, jnp.einsum('bhnik,bhnjk->bhnij', kb, kc) * decay, 0.0)
    a_mat = lmat + jnp.eye(c, dtype=jnp.float32)
    u = lax.linalg.triangular_solve(a_mat, vb, left_side=True, lower=True, unit_diagonal=True)
    w = lax.linalg.triangular_solve(a_mat, kb * jnp.exp(G)[..., None], left_side=True, lower=True,
                                    unit_diagonal=True)
    qk = jnp.einsum('bhnik,bhnjk->bhnij', qc, kc) * decay
    q_dec = qc * jnp.exp(G)[..., None]
    g_last = G[..., -1]
    k_dec = kc * jnp.exp(g_last[..., None] - G)[..., None]

    def step(s, xs):
        u_n, w_n, qk_n, qd_n, kd_n, gl_n = xs
        v_new = u_n - jnp.einsum('bhck,bhkv->bhcv', w_n, s)
        o_n = jnp.einsum('bhck,bhkv->bhcv', qd_n, s) + jnp.einsum('bhij,bhjv->bhiv', qk_n, v_new)
        s = s * jnp.exp(gl_n)[..., None, None] + jnp.einsum('bhck,bhcv->bhkv', kd_n, v_new)
        return s, o_n

    xs = tuple(jnp.moveaxis(a, 2, 0) for a in (u, w, qk, q_dec, k_dec, g_last))
    s_final, o = lax.scan(step, s0.astype(jnp.float32), xs)
    o = jnp.moveaxis(o, 0, 2).reshape(b, h, n * c, dv)[:, :, :t]
    return jnp.moveaxis(o, 1, 2), s_final


def dilated_mixture(q, k_all, v_all, q_index):
    scale = HEAD_DIM_B ** -0.5
    qf = q.astype(jnp.float32)
    outs, lses = [], []
    for window, dil in DILATED_PATTERNS:
        offs = jnp.arange(window // dil + 1) * dil
        idx = q_index[:, None] - offs[None, :]
        valid = idx >= 0
        idx = jnp.maximum(idx, 0)
        kg = jnp.take(k_all, idx, axis=1).astype(jnp.float32)
        vg = jnp.take(v_all, idx, axis=1).astype(jnp.float32)
        s = jnp.einsum('bqhd,bqjhd->bqhj', qf, kg) * scale
        s = jnp.where(valid[None, :, None, :], s, -jnp.inf)
        lse = jax.nn.logsumexp(s, axis=-1)
        p = jnp.exp(s - lse[..., None])
        outs.append(jnp.einsum('bqhj,bqjhd->bqhd', p, vg))
        lses.append(lse)
    wts = jax.nn.softmax(jnp.stack(lses), axis=0)
    return jnp.einsum('gbqh,gbqhd->bqhd', wts, jnp.stack(outs))


def dilated_attention(q, k_all, v_all, base):
    b, t, h, dh = q.shape
    if t % Q_BLOCK == 0:
        nb = t // Q_BLOCK
        qb = q.reshape(b, nb, Q_BLOCK, h, dh).swapaxes(0, 1)

        def blk(args):
            i, qblk = args
            return dilated_mixture(qblk, k_all, v_all, base + i * Q_BLOCK + jnp.arange(Q_BLOCK))

        o = lax.map(blk, (jnp.arange(nb), qb))
        return o.swapaxes(0, 1).reshape(b, t, h, dh)
    return dilated_mixture(q, k_all, v_all, base + jnp.arange(t))


def trunk_layer(x, conv_buf, s0, k_past, v_past, norm1_g, w_in, conv_w, a_log, dt_bias,
                delta_norm_g, q_norm_g, k_norm_g, w_o, norm2_g, w_up, w_down):
    b, t, _ = x.shape
    hn = rmsnorm(x, norm1_g)
    proj = hn @ w_in
    cuts = [int(c) for c in np.cumsum(SPLIT_SIZES)[:-1]]
    qkv_a, z_a, b_a, a_a, q_b, k_b, v_b = jnp.split(proj, cuts, axis=-1)

    qkv_a, conv_new = short_conv(qkv_a, conv_buf, conv_w)
    qa, ka, va = jnp.split(qkv_a, 3, axis=-1)
    qa = l2norm(qa.reshape(b, t, N_HEADS_A, HEAD_DIM_A)) * (HEAD_DIM_A ** -0.5)
    ka = l2norm(ka.reshape(b, t, N_HEADS_A, HEAD_DIM_A))
    va = va.reshape(b, t, N_HEADS_A, HEAD_DIM_A)
    beta = jax.nn.sigmoid(b_a.astype(jnp.float32))
    g = -jnp.exp(a_log.astype(jnp.float32)) * jax.nn.softplus(
        a_a.astype(jnp.float32) + dt_bias.astype(jnp.float32))
    oa, s_new = gated_delta_chunked(qa, ka, va, beta, g, s0)
    oa = rmsnorm(oa, delta_norm_g) * jax.nn.silu(
        z_a.reshape(b, t, N_HEADS_A, HEAD_DIM_A).astype(jnp.float32))
    oa = oa.reshape(b, t, WIDTH_A).astype(x.dtype)

    qb = rmsnorm(q_b.reshape(b, t, N_HEADS_B, HEAD_DIM_B), q_norm_g)
    kb = rmsnorm(k_b.reshape(b, t, N_HEADS_B, HEAD_DIM_B), k_norm_g)
    vb = v_b.reshape(b, t, N_HEADS_B, HEAD_DIM_B)
    k_all = jnp.concatenate([k_past.astype(kb.dtype), kb], axis=1)
    v_all = jnp.concatenate([v_past.astype(vb.dtype), vb], axis=1)
    ob = dilated_attention(qb, k_all, v_all, k_past.shape[1])
    ob = ob.reshape(b, t, WIDTH_B).astype(x.dtype)

    h1 = x + jnp.concatenate([oa, ob], axis=-1) @ w_o
    hid = jnp.square(jax.nn.relu(rmsnorm(h1, norm2_g) @ w_up))
    y = h1 + hid @ w_down
    return y, kb, vb, s_new, conv_new


def setup_inputs(seed: int = 0) -> dict:
    key = jax.random.key(seed)
    ks = jax.random.split(key, 20)
    wbuf = min(MAX_WINDOW, PAST_LEN)
    f32 = jnp.float32
    dt = jnp.exp(jax.random.uniform(ks[10], (DEPTH, N_HEADS_A), f32, np.log(1e-3), np.log(1e-1)))
    return {
        "x_prompt": jax.random.normal(ks[0], (BATCH, SEQ, D_MODEL), f32),
        "x_sample": jax.random.normal(ks[1], (DEC_BATCH, DEC_SEQ, D_MODEL), f32),
        "cache_swa_k": jax.random.normal(ks[2], (DEPTH, DEC_BATCH, wbuf, N_HEADS_B, HEAD_DIM_B), f32),
        "cache_swa_v": jax.random.normal(ks[3], (DEPTH, DEC_BATCH, wbuf, N_HEADS_B, HEAD_DIM_B), f32),
        "state_delta": 0.1 * jax.random.normal(ks[4], (DEPTH, DEC_BATCH, N_HEADS_A, HEAD_DIM_A, HEAD_DIM_A), f32),
        "state_conv": jax.random.normal(ks[5], (DEPTH, DEC_BATCH, CONV_WIDTH - 1, CONV_CH), f32),
        "norm1_g": 1.0 + 0.05 * jax.random.normal(ks[6], (DEPTH, D_MODEL), f32),
        "w_in": jax.random.normal(ks[7], (DEPTH, D_MODEL, PROJ_COLS), f32) * D_MODEL ** -0.5,
        "conv_w": jax.random.normal(ks[8], (DEPTH, CONV_WIDTH, CONV_CH), f32) * CONV_WIDTH ** -0.5,
        "a_log": jnp.log(jax.random.uniform(ks[9], (DEPTH, N_HEADS_A), f32, 1.0, 16.0)),
        "dt_bias": dt + jnp.log(-jnp.expm1(-dt)),
        "delta_norm_g": 1.0 + 0.05 * jax.random.normal(ks[11], (DEPTH, HEAD_DIM_A), f32),
        "q_norm_g": 1.0 + 0.05 * jax.random.normal(ks[12], (DEPTH, HEAD_DIM_B), f32),
        "k_norm_g": 1.0 + 0.05 * jax.random.normal(ks[13], (DEPTH, HEAD_DIM_B), f32),
        "w_o": jax.random.normal(ks[14], (DEPTH, MIX_WIDTH, D_MODEL), f32) * MIX_WIDTH ** -0.5,
        "norm2_g": 1.0 + 0.05 * jax.random.normal(ks[15], (DEPTH, D_MODEL), f32),
        "w_up": jax.random.normal(ks[16], (DEPTH, D_MODEL, D_FF), f32) * D_MODEL ** -0.5,
        "w_down": jax.random.normal(ks[17], (DEPTH, D_FF, D_MODEL), f32) * D_FF ** -0.5,
    }


def reference(x_prompt, x_sample, cache_swa_k, cache_swa_v, state_delta, state_conv, norm1_g, w_in,
              conv_w, a_log, dt_bias, delta_norm_g, q_norm_g, k_norm_g, w_o, norm2_g, w_up, w_down):
    b, s, _ = x_prompt.shape
    pbuf = min(MAX_WINDOW, s)
    yp, ys = x_prompt, x_sample
    kp_l, vp_l, dp_l, cp_l, ks_l, vs_l, ds_l, cs_l = [], [], [], [], [], [], [], []
    for layer in range(DEPTH):
        params = (norm1_g[layer], w_in[layer], conv_w[layer], a_log[layer], dt_bias[layer],
                  delta_norm_g[layer], q_norm_g[layer], k_norm_g[layer], w_o[layer], norm2_g[layer],
                  w_up[layer], w_down[layer])
        zero_kv = jnp.zeros((b, 0, N_HEADS_B, HEAD_DIM_B), yp.dtype)
        yp, kp, vp, dp, cp = trunk_layer(
            yp, jnp.zeros((b, CONV_WIDTH - 1, CONV_CH), yp.dtype),
            jnp.zeros((b, N_HEADS_A, HEAD_DIM_A, HEAD_DIM_A), jnp.float32),
            zero_kv, zero_kv, *params)
        kp_l.append(kp[:, -pbuf:]); vp_l.append(vp[:, -pbuf:]); dp_l.append(dp); cp_l.append(cp)
        ys, kn, vn, dn, cn = trunk_layer(
            ys, state_conv[layer], state_delta[layer], cache_swa_k[layer], cache_swa_v[layer], *params)
        ks_l.append(kn); vs_l.append(vn); ds_l.append(dn); cs_l.append(cn)
    return (yp, ys, jnp.stack(kp_l), jnp.stack(vp_l), jnp.stack(dp_l), jnp.stack(cp_l),
            jnp.stack(ks_l), jnp.stack(vs_l), jnp.stack(ds_l), jnp.stack(cs_l))
```

```cpp
#include <hip/hip_runtime.h>
#include <cstdio>
#include <cstdint>
namespace pg8 {
#define PG8_LAS __attribute__((address_space(3)))
typedef unsigned short bf16_t;
typedef short bf16x8 __attribute__((ext_vector_type(8)));
typedef float f32x4 __attribute__((ext_vector_type(4)));
typedef unsigned u32x4 __attribute__((ext_vector_type(4)));
constexpr int BM = 256, BK = 64, HALF = 128, HTB = HALF * BK * 2  , STAGE_BYTES = 8 * HTB, NXCD = 8, WGM = 8;

__host__ __device__ __forceinline__ int lds_byte(int r, int c) { const int st = (r >> 4) * 2 + (c >> 5), rr = r & 15, cc = c & 31, ob = rr * 64 + cc * 2; return st * 1024 + (ob ^ (((ob >> 9) & 1) << 5)); }
__host__ __device__ __forceinline__ void stage_rc(int b, int& R, int& C) { const int st = b / 1024, sb = b % 1024, swz = sb ^ (((sb >> 9) & 1) << 5); R = (st >> 1) * 16 + swz / 64; C = (st & 1) * 32 + (swz % 64) / 2; }
__host__ __device__ __forceinline__ int perm32(int rho) { const int n = rho >> 4, i = rho & 15; return 8 * (i >> 2) + 4 * n + (i & 3); }

struct Unit { int pm, pn; };
struct Gemm { const bf16_t* A; const bf16_t* Bt; int M, N, K; };

struct StaticOrder {
    int nM, nN, nwg, G, c;
    __host__ __device__ void init(int M, int N, int G_, int c_) { nM = M / BM; nN = N / BM; nwg = nM * nN; G = G_; c = c_; }
    __host__ __device__ bool next(int i, Unit& u) const {
        const long L = (long)i * G + c; if (L >= nwg) return false;
        int wgid = (int)L; { const int q = nwg / NXCD, r = nwg % NXCD, xcd = wgid % NXCD, off = wgid / NXCD; wgid = (xcd < r ? xcd * (q + 1) : r * (q + 1) + (xcd - r) * q) + off; }
        const int nig = WGM * nN, gid = wgid / nig, fm = gid * WGM, gsz = (nM - fm) < WGM ? (nM - fm) : WGM;
        u.pm = fm + ((wgid % nig) % gsz); u.pn = (wgid % nig) / gsz; return true;
    }
    __device__ __forceinline__ void a_ready(const Unit&) const {}
    __device__ __forceinline__ void done(const Unit&) const {}
};

typedef float f32x2 __attribute__((ext_vector_type(2)));
typedef __bf16 bf16x2 __attribute__((ext_vector_type(2)));
__device__ __forceinline__ unsigned cvt_pk_bf16(float lo, float hi) { f32x2 v = {lo, hi}; bf16x2 b = __builtin_convertvector(v, bf16x2); return __builtin_bit_cast(unsigned, b); }
template <int ACT> struct EpiBf16 {
    static constexpr bool PERM = true, AFTER_DRAIN = false;
    bf16_t* O; int ldc;
    __device__ __forceinline__ void operator()(const f32x4 (&acc)[2][2][4][2], const Unit& u, int wr, int wc, int fr, int fq) const {
        const int row0 = u.pm * BM + wr * 64 + fr; const int col0 = u.pn * BM + wc * 32 + 8 * fq;
#pragma unroll
        for (int ai = 0; ai < 2; ++ai)
#pragma unroll
            for (int m = 0; m < 4; ++m) { bf16_t* rowp = O + (size_t)(row0 + ai * HALF + m * 16) * ldc + col0;
#pragma unroll
                for (int bj = 0; bj < 2; ++bj) { f32x4 v0 = acc[ai][bj][m][0], v1 = acc[ai][bj][m][1];
                    if (ACT == 2) {
#pragma unroll
                        for (int e = 0; e < 4; ++e) { const float a = fmaxf(v0[e], 0.f), b = fmaxf(v1[e], 0.f); v0[e] = a * a; v1[e] = b * b; } }
                    u32x4 w; w.x = cvt_pk_bf16(v0[0], v0[1]); w.y = cvt_pk_bf16(v0[2], v0[3]); w.z = cvt_pk_bf16(v1[0], v1[1]); w.w = cvt_pk_bf16(v1[2], v1[3]);
                    *(u32x4*)(rowp + bj * HALF) = w; } }
    }
};
struct EpiResF32 {
    static constexpr bool PERM = false, AFTER_DRAIN = false;
    const float* base; const float* base2; int split; float* out; int ldc;
    __device__ __forceinline__ void operator()(const f32x4 (&acc)[2][2][4][2], const Unit& u, int wr, int wc, int fr, int fq) const {
        const int col0 = u.pn * BM + wc * 32 + 4 * fq;
        const float* bs = (u.pm * BM >= split) ? base2 - (size_t)split * ldc : base;
#pragma unroll
        for (int ai = 0; ai < 2; ++ai)
#pragma unroll
            for (int m = 0; m < 4; ++m) { const size_t off = (size_t)(u.pm * BM + ai * HALF + wr * 64 + m * 16 + fr) * ldc + col0;
#pragma unroll
                for (int bj = 0; bj < 2; ++bj)
#pragma unroll
                    for (int n = 0; n < 2; ++n) { const f32x4 b = *(const f32x4*)(bs + off + bj * HALF + n * 16); *(f32x4*)(out + off + bj * HALF + n * 16) = b + acc[ai][bj][m][n]; }
                if (m & 1) asm volatile("" ::: "memory"); }
    }
};
template <class Epi, class Sched, bool ALIGN_EPI = false, bool SP2 = false>
__device__ __forceinline__ void gemm_phase(PG8_LAS unsigned char* lds, const Gemm g, const Sched& S, const Epi& E) {
    const int tid = threadIdx.x, wid = __builtin_amdgcn_readfirstlane(tid >> 6), lane = tid & 63, wr = wid >> 2, wc = wid & 3, fr = lane & 15, fq = lane >> 4;
    const int K = g.K, nt = K / BK;
    unsigned voffA[2], voffB[2];
#pragma unroll
    for (int i = 0; i < 2; ++i) { int R, C; stage_rc(tid * 16 + i * 8192, R, C); const int Rb = Epi::PERM ? ((R & ~31) + perm32(R & 31)) : R;
        voffA[i] = (unsigned)(R * K + C) * 2u; voffB[i] = (unsigned)(Rb * K + C) * 2u; }
    const size_t kstep = (size_t)(BK * 2);
    const size_t hstep = (size_t)HALF * K * 2;
    const size_t tstep = 2 * hstep;
    const unsigned ldsw = (unsigned)wid * 1024u;
    const int aoff = lds_byte(wr * 64 + fr, fq * 8), boff = lds_byte(wc * 32 + fr, fq * 8);
#define PG8_SA(b, h) (((b) * 2 + (h)) * HTB)
#define PG8_SB(b, h) ((4 + (b) * 2 + (h)) * HTB)
#define PG8_STAGE(bufoff, gbase, voff) do { _Pragma("unroll") for (int _i = 0; _i < 2; ++_i) \
        __builtin_amdgcn_global_load_lds((const unsigned*)((const char*)(gbase) + (voff)[_i]), (PG8_LAS unsigned*)(lds + (bufoff) + ldsw + _i * 8192), 16, 0, 0); } while (0)
#define PG8_LDA(dst, b, h) do { _Pragma("unroll") for (int m = 0; m < 4; ++m) _Pragma("unroll") for (int k = 0; k < 2; ++k) dst[m][k] = *(const PG8_LAS bf16x8*)(lds + PG8_SA(b, h) + aoff + m * 2048 + k * 1024); } while (0)
#define PG8_LDB(dst, b, h) do { _Pragma("unroll") for (int n = 0; n < 2; ++n) _Pragma("unroll") for (int k = 0; k < 2; ++k) dst[n][k] = *(const PG8_LAS bf16x8*)(lds + PG8_SB(b, h) + boff + n * 2048 + k * 1024); } while (0)
#define PG8_MMA(ai, bj, At, Bt) do { __builtin_amdgcn_s_setprio(1); _Pragma("unroll") for (int m = 0; m < 4; ++m) _Pragma("unroll") for (int n = 0; n < 2; ++n) _Pragma("unroll") for (int k = 0; k < 2; ++k) \
        acc[ai][bj][m][n] = __builtin_amdgcn_mfma_f32_16x16x32_bf16(Bt[n][k], At[m][k], acc[ai][bj][m][n], 0, 0, 0); __builtin_amdgcn_s_setprio(0); } while (0)
#define PG8_WAIT_V(n) asm volatile("s_waitcnt vmcnt(" #n ")" ::: "memory")
#define PG8_WAIT_L(n) asm volatile("s_waitcnt lgkmcnt(" #n ")" ::: "memory")
#define PG8_BAR __builtin_amdgcn_s_barrier()
#define PG8_SCHED __builtin_amdgcn_sched_barrier(0)
    Unit cur, nxt; int ui = 0;
    if (!S.next(0, cur)) return;
    f32x4 acc[2][2][4][2];
#pragma unroll
    for (int a = 0; a < 2; ++a)
#pragma unroll
        for (int b = 0; b < 2; ++b)
#pragma unroll
            for (int m = 0; m < 4; ++m)
#pragma unroll
                for (int n = 0; n < 2; ++n) acc[a][b][m][n] = (f32x4){0.f, 0.f, 0.f, 0.f};
    bf16x8 At[4][2], B0[2][2], B1[2][2];
    const char* cA = (const char*)g.A + (size_t)cur.pm * tstep; const char* cB = (const char*)g.Bt + (size_t)cur.pn * tstep;
    S.a_ready(cur);
    if constexpr (SP2) {
        PG8_STAGE(PG8_SB(0, 0), cB, voffB); PG8_STAGE(PG8_SB(0, 1), cB + hstep, voffB); PG8_STAGE(PG8_SA(0, 0), cA, voffA); PG8_STAGE(PG8_SA(0, 1), cA + hstep, voffA);
        if (wr == 1) PG8_BAR;
        PG8_WAIT_V(2); PG8_BAR;
        PG8_STAGE(PG8_SB(1, 0), cB + kstep, voffB); PG8_STAGE(PG8_SA(1, 0), cA + kstep, voffA); PG8_STAGE(PG8_SB(1, 1), cB + hstep + kstep, voffB);
        PG8_WAIT_V(6); PG8_BAR;
    } else {
        PG8_STAGE(PG8_SB(0, 0), cB, voffB); PG8_STAGE(PG8_SA(0, 0), cA, voffA); PG8_STAGE(PG8_SB(0, 1), cB + hstep, voffB); PG8_STAGE(PG8_SA(0, 1), cA + hstep, voffA);
        if (wr == 1) PG8_BAR;
        PG8_WAIT_V(4); PG8_BAR;
        PG8_STAGE(PG8_SB(1, 0), cB + kstep, voffB); PG8_STAGE(PG8_SA(1, 0), cA + kstep, voffA); PG8_STAGE(PG8_SB(1, 1), cB + hstep + kstep, voffB);
        PG8_WAIT_V(6); PG8_BAR;
    }
    for (;;) {
        const bool has_next = S.next(ui + 1, nxt);
        const char* nA = has_next ? (const char*)g.A + (size_t)nxt.pm * tstep : cA; const char* nB = has_next ? (const char*)g.Bt + (size_t)nxt.pn * tstep : cB;
        for (int t = 0; t < nt; t += 2) {
            const bool last = (t == nt - 2);
            const char* a1 = cA + (size_t)(t + 1) * kstep;
            const char* a2 = last ? nA : cA + (size_t)(t + 2) * kstep; const char* b2 = last ? nB : cB + (size_t)(t + 2) * kstep;
            const char* a3 = a2 + kstep; const char* b3 = b2 + kstep;
            if (last && has_next) S.a_ready(nxt);
            if constexpr (SP2) {
            PG8_LDB(B0, 0, 0); PG8_LDB(B1, 0, 1); PG8_SCHED; PG8_LDA(At, 0, 0); PG8_STAGE(PG8_SA(1, 1), a1 + hstep, voffA);
            PG8_WAIT_V(8); PG8_WAIT_L(0); PG8_BAR; PG8_MMA(0, 0, At, B0); PG8_MMA(0, 1, At, B1); PG8_BAR; PG8_SCHED;
            PG8_LDA(At, 0, 1); PG8_STAGE(PG8_SB(0, 0), b2, voffB); PG8_STAGE(PG8_SB(0, 1), b2 + hstep, voffB); PG8_STAGE(PG8_SA(0, 0), a2, voffA);
            PG8_WAIT_V(8); PG8_WAIT_L(0); PG8_BAR; PG8_MMA(1, 0, At, B0); PG8_MMA(1, 1, At, B1); PG8_BAR; PG8_SCHED;
            PG8_LDB(B0, 1, 0); PG8_LDB(B1, 1, 1); PG8_SCHED; PG8_LDA(At, 1, 0); PG8_STAGE(PG8_SA(0, 1), a2 + hstep, voffA);
            PG8_WAIT_V(8); PG8_WAIT_L(0); PG8_BAR; PG8_MMA(0, 0, At, B0); PG8_MMA(0, 1, At, B1); PG8_BAR; PG8_SCHED;
            PG8_LDA(At, 1, 1); PG8_STAGE(PG8_SB(1, 0), b3, voffB); PG8_STAGE(PG8_SB(1, 1), b3 + hstep, voffB); PG8_STAGE(PG8_SA(1, 0), a3, voffA);
            PG8_WAIT_V(8); PG8_WAIT_L(0); PG8_BAR; PG8_MMA(1, 0, At, B0); PG8_MMA(1, 1, At, B1); PG8_BAR; PG8_SCHED;
            } else {
            PG8_LDB(B0, 0, 0); PG8_SCHED; PG8_LDA(At, 0, 0); PG8_STAGE(PG8_SA(1, 1), a1 + hstep, voffA);
            PG8_WAIT_L(8); PG8_BAR; PG8_WAIT_L(0); PG8_MMA(0, 0, At, B0); PG8_BAR; PG8_SCHED;
            PG8_LDB(B1, 0, 1); PG8_STAGE(PG8_SB(0, 0), b2, voffB);
            PG8_BAR; PG8_WAIT_L(0); PG8_MMA(0, 1, At, B1); PG8_BAR;
            PG8_LDA(At, 0, 1); PG8_STAGE(PG8_SA(0, 0), a2, voffA);
            PG8_BAR; PG8_WAIT_L(0); PG8_MMA(1, 0, At, B0); PG8_BAR; PG8_SCHED;
            PG8_STAGE(PG8_SB(0, 1), b2 + hstep, voffB);
            PG8_WAIT_V(6); PG8_BAR; PG8_MMA(1, 1, At, B1); PG8_BAR;
            PG8_LDB(B0, 1, 0); PG8_SCHED; PG8_LDA(At, 1, 0); PG8_STAGE(PG8_SA(0, 1), a2 + hstep, voffA);
            PG8_WAIT_L(8); PG8_BAR; PG8_WAIT_L(0); PG8_MMA(0, 0, At, B0); PG8_BAR; PG8_SCHED;
            PG8_LDB(B1, 1, 1); PG8_STAGE(PG8_SB(1, 0), b3, voffB);
            PG8_BAR; PG8_WAIT_L(0); PG8_MMA(0, 1, At, B1); PG8_BAR;
            PG8_LDA(At, 1, 1); PG8_STAGE(PG8_SA(1, 0), a3, voffA);
            PG8_BAR; PG8_WAIT_L(0); PG8_MMA(1, 0, At, B0); PG8_BAR; PG8_SCHED;
            PG8_STAGE(PG8_SB(1, 1), b3 + hstep, voffB);
            PG8_WAIT_V(6); PG8_BAR; PG8_MMA(1, 1, At, B1); PG8_BAR;
            }
        }
        if constexpr (ALIGN_EPI) { if (wr == 0) PG8_BAR; }
        if constexpr (!Epi::AFTER_DRAIN) { E(acc, cur, wr, wc, fr, fq); S.done(cur); }
        if (!has_next) break;
#pragma unroll
        for (int a = 0; a < 2; ++a)
#pragma unroll
            for (int b = 0; b < 2; ++b)
#pragma unroll
                for (int m = 0; m < 4; ++m)
#pragma unroll
                    for (int n = 0; n < 2; ++n) acc[a][b][m][n] = (f32x4){0.f, 0.f, 0.f, 0.f};
        cur = nxt; cA = nA; cB = nB; ++ui;
        if constexpr (ALIGN_EPI) { if (wr == 1) PG8_BAR; }
    }
    PG8_WAIT_V(0);
    if constexpr (!ALIGN_EPI) { if (wr == 0) PG8_BAR; }
    PG8_BAR;
    if constexpr (Epi::AFTER_DRAIN) { E.fused(acc, cur, wr, wc, fr, fq, lds, wid, lane); S.done(cur); }
#undef PG8_SA
#undef PG8_SB
#undef PG8_STAGE
#undef PG8_LDA
#undef PG8_LDB
#undef PG8_MMA
#undef PG8_WAIT_V
#undef PG8_WAIT_L
#undef PG8_BAR
#undef PG8_SCHED
}
}

#ifndef PG8_SP2
#define PG8_SP2 true
#endif
#ifndef PG8_ALIGN
#define PG8_ALIGN true
#endif
#ifndef MK_ONE_LAUNCH
#define MK_ONE_LAUNCH 0
#endif

constexpr int NWAVES = 8;
constexpr int D = 1024, NB = 4, SEQ = 4096, MP = NB * SEQ, NSB = 128, ST = 8, MS = NSB * ST, M = MP + MS;
constexpr int HA = 4, DA = 128, WA = 512, HB = 8, DB = 64, WB = 512, CONVC = 1536, FF = 4096, WBUF = 2048;
constexpr int PCOLS = 3592, NPROJ = 3584;
constexpr int PC_Z = 1536, PC_QB = 2048, PC_KB = 2560, PC_VB = 3072;
constexpr int NCH = SEQ / 64, NBH = NB * HA;
constexpr float EPS = 1e-6f;
constexpr float QB_SCALE = 0.125f * 1.4426950408889634f;

constexpr size_t O_YP = 0, O_YS = (size_t)MP * D, O_KP = O_YS + (size_t)MS * D, O_VP = O_KP + (size_t)NB * WBUF * WB, O_DP = O_VP + (size_t)NB * WBUF * WB,
                 O_CP = O_DP + (size_t)NBH * DA * DA, O_KS = O_CP + (size_t)NB * 3 * CONVC, O_VS = O_KS + (size_t)MS * WB, O_DS = O_VS + (size_t)MS * WB,
                 O_CS = O_DS + (size_t)NSB * HA * DA * DA, O_END = O_CS + (size_t)NSB * 3 * CONVC;
static_assert(O_END == 36521984, "output size");

constexpr size_t al256(size_t x) { return (x + 255) & ~(size_t)255; }
constexpr size_t WS_CTL = 0, CTL_ZERO_BYTES = 1u << 20;
constexpr size_t WS_WIN = CTL_ZERO_BYTES;
constexpr size_t WS_WO = WS_WIN + (size_t)NPROJ * D * 2;
constexpr size_t WS_WUP = WS_WO + (size_t)D * D * 2;
constexpr size_t WS_WDN = WS_WUP + (size_t)FF * D * 2;
constexpr size_t WS_XN = WS_WDN + (size_t)FF * D * 2;
constexpr size_t WS_PROJ = WS_XN + (size_t)M * D * 2;
constexpr size_t WS_BETA = WS_PROJ + (size_t)M * NPROJ * 2;
constexpr size_t WS_GG = WS_BETA + (size_t)M * 4 * 4;
constexpr size_t WS_GC = WS_GG + (size_t)M * 4 * 4;
constexpr size_t WS_QA = WS_GC + (size_t)NBH * SEQ * 4;
constexpr size_t WS_KA = WS_QA + (size_t)NBH * SEQ * DA * 2;
constexpr size_t WS_KAT = WS_KA + (size_t)NBH * SEQ * DA * 2;
constexpr size_t WS_VAT = WS_KAT + (size_t)NBH * SEQ * DA * 2;
constexpr size_t WS_WF = WS_VAT + (size_t)NBH * SEQ * DA * 2;
constexpr size_t WS_UF = WS_WF + (size_t)NBH * NCH * 16 * 1024;
constexpr size_t WS_QKF = WS_UF + (size_t)NBH * NCH * 32 * 1024;
constexpr size_t WS_OA = WS_QKF + (size_t)NBH * NCH * 8 * 1024;
constexpr size_t WS_Q16 = WS_OA + (size_t)M * WA * 4;
constexpr size_t WS_K16 = WS_Q16 + (size_t)MP * WB * 2;
constexpr size_t WS_VT16 = WS_K16 + (size_t)MP * WB * 2;
constexpr size_t WS_QSB = WS_VT16 + (size_t)MP * WB * 2;
constexpr size_t WS_QKVS = WS_QSB + (size_t)MS * WB * 4;
constexpr size_t WS_MIX = WS_QKVS + (size_t)MS * CONVC * 4;
constexpr size_t WS_HID = WS_MIX + (size_t)M * D * 2;
constexpr size_t WS_END = WS_HID + (size_t)M * FF * 2;
static_assert(WS_END % 256 == 0 && WS_WIN % 256 == 0, "ws alignment");
constexpr int CW_BAR = 4096;

constexpr int RING_OFF = 0, RING_BYTES = 131072;
constexpr int LDSCTL_OFF = RING_BYTES, MISC_OFF = LDSCTL_OFF + 320;
constexpr int LDS_BYTES = 147456;

#define GAS __attribute__((address_space(1)))
#define LAS __attribute__((address_space(3)))
typedef unsigned short bf16;
typedef unsigned v4u __attribute__((ext_vector_type(4)));
typedef float f32x4 __attribute__((ext_vector_type(4)));
typedef short bf16x8 __attribute__((ext_vector_type(8)));
typedef GAS unsigned gu32;
typedef GAS unsigned long long gu64;
#define RLX_AGENT __ATOMIC_RELAXED, __HIP_MEMORY_SCOPE_AGENT
#define LDS_WAIT() asm volatile("s_waitcnt lgkmcnt(0)" ::: "memory")
#define VM_WAIT() asm volatile("s_waitcnt vmcnt(0)" ::: "memory")
__device__ __forceinline__ unsigned long long rt() { return __builtin_amdgcn_s_memrealtime(); }
__device__ __forceinline__ unsigned f2bf(float f) { unsigned u = __builtin_bit_cast(unsigned, f); return (u + 0x7fffu + ((u >> 16) & 1u)) >> 16; }
__device__ __forceinline__ unsigned pk2(float lo, float hi) { return f2bf(lo) | (f2bf(hi) << 16); }

#define XB_TMO      128
#define XB_XCNT(j)  (256  + 64 * (j))
#define XB_XSUB(j)  (1280 + 64 * (j))
#define XB_XGEN(j)  (2304 + 64 * (j))
#define XB_TOP      3328
#define XB_TOPGEN   3392
#define XCD_BAR_WORDS 3456
#define XB_SPIN_CAP (1u << 18)

__device__ __forceinline__ unsigned xb_ld(unsigned* p)              { return __hip_atomic_load(p, __ATOMIC_RELAXED, __HIP_MEMORY_SCOPE_AGENT); }
__device__ __forceinline__ unsigned xb_add(unsigned* p, unsigned v) { return __hip_atomic_fetch_add(p, v, __ATOMIC_RELAXED, __HIP_MEMORY_SCOPE_AGENT); }
__device__ __forceinline__ unsigned xb_xcc_id() { return (unsigned)__builtin_amdgcn_s_getreg((3 << 11) | 20) & 0xFu; }
#define XB_SPIN(cond, bar) do { unsigned _sp = 0; while (cond) { __builtin_amdgcn_s_sleep(1); \
    if ((++_sp & 255u) == 0u) { if (xb_ld(&(bar)[XB_TMO])) break; if (_sp > XB_SPIN_CAP) { atomicAdd(&(bar)[XB_TMO], 1u); break; } } } } while (0)

struct XcdBarrier {
    unsigned* bar; unsigned x;
    volatile LAS unsigned* st;
};

__device__ __forceinline__ XcdBarrier xcd_barrier_post(unsigned* bar, volatile LAS unsigned* st) {
    XcdBarrier b; b.bar = bar; b.x = xb_xcc_id(); b.st = st;
    if (threadIdx.x == 0) (void)xb_add(&bar[XB_XCNT(b.x)], 1u);
    return b;
}
__device__ __forceinline__ void xcd_barrier_complete(unsigned* bar, unsigned x, unsigned& nloc, unsigned& nx) {
    const unsigned G = gridDim.x * gridDim.y * gridDim.z;
    unsigned sum, cnt, mine, sp = 0u;
    for (;;) {
        sum = 0u; cnt = 0u; mine = 0u;
#pragma unroll
        for (unsigned j = 0; j < 16; ++j) { const unsigned c = xb_ld(&bar[XB_XCNT(j)]); sum += c; cnt += (c > 0u) ? 1u : 0u; mine = (j == x) ? c : mine; }
        if (sum == G) break;
        __builtin_amdgcn_s_sleep(1);
        if ((++sp & 255u) == 0u) { if (xb_ld(&bar[XB_TMO])) break; if (sp > XB_SPIN_CAP) { atomicAdd(&bar[XB_TMO], 1u); break; } }
    }
    nloc = mine > 0u ? mine : 1u; nx = cnt > 0u ? cnt : 1u;
}

__device__ __forceinline__ void xcd_barrier(const XcdBarrier& b) {
    asm volatile("s_waitcnt vmcnt(0)" ::: "memory");
    __syncthreads();
    if (threadIdx.x == 0) {
        unsigned* bar = b.bar;
        __builtin_amdgcn_s_waitcnt(0);
        unsigned nloc = b.st[0], nx = b.st[1];
        if (nloc == 0u) { xcd_barrier_complete(bar, b.x, nloc, nx); b.st[0] = nloc; b.st[1] = nx; }
        const unsigned old = xb_add(&bar[XB_XSUB(b.x)], 1u);
        const unsigned gen = old / nloc;
        if (old + 1u == (gen + 1u) * nloc) {
            __builtin_amdgcn_fence(__ATOMIC_RELEASE, "agent");
            asm volatile("s_waitcnt vmcnt(0)" ::: "memory");
            const unsigned og = xb_add(&bar[XB_TOP], 1u);
            const unsigned tg = og / nx;
            if (og + 1u == (tg + 1u) * nx) xb_add(&bar[XB_TOPGEN], 1u);
            else XB_SPIN(xb_ld(&bar[XB_TOPGEN]) == tg, bar);
            __builtin_amdgcn_fence(__ATOMIC_ACQUIRE, "agent");
            xb_add(&bar[XB_XGEN(b.x)], 1u);
            asm volatile("s_waitcnt vmcnt(0)" ::: "memory");
        } else {
            XB_SPIN(xb_ld(&bar[XB_XGEN(b.x)]) == gen, bar);
            __builtin_amdgcn_fence(__ATOMIC_ACQUIRE, "agent");
            asm volatile("s_waitcnt vmcnt(0)" ::: "memory");
        }
    }
    __syncthreads();
}


typedef float f32x2v __attribute__((ext_vector_type(2)));
typedef unsigned u32x2v __attribute__((ext_vector_type(2)));
typedef __bf16 bf16x2_t __attribute__((ext_vector_type(2)));
__device__ __forceinline__ unsigned cvtpk(float lo, float hi) { f32x2v v = {lo, hi}; bf16x2_t b = __builtin_convertvector(v, bf16x2_t); return __builtin_bit_cast(unsigned, b); }
__device__ __forceinline__ float bflo(unsigned u) { return __uint_as_float(u << 16); }
__device__ __forceinline__ float bfhi(unsigned u) { return __uint_as_float(u & 0xffff0000u); }
__device__ __forceinline__ void unpack8(const v4u w, float (&f)[8]) { f[0] = bflo(w.x); f[1] = bfhi(w.x); f[2] = bflo(w.y); f[3] = bfhi(w.y); f[4] = bflo(w.z); f[5] = bfhi(w.z); f[6] = bflo(w.w); f[7] = bfhi(w.w); }
__device__ __forceinline__ v4u pack8(const float (&f)[8]) { v4u w; w.x = cvtpk(f[0], f[1]); w.y = cvtpk(f[2], f[3]); w.z = cvtpk(f[4], f[5]); w.w = cvtpk(f[6], f[7]); return w; }
__device__ __forceinline__ float silu_f(float x) { return x / (1.f + __expf(-x)); }
__device__ __forceinline__ bf16x8 as_bf16x8(v4u w) { return __builtin_bit_cast(bf16x8, w); }
__device__ __forceinline__ f32x4 mfma16(bf16x8 a, bf16x8 b, f32x4 c) { return __builtin_amdgcn_mfma_f32_16x16x32_bf16(a, b, c, 0, 0, 0); }
__device__ __forceinline__ int perm_tok(int x) { return 8 * ((x >> 2) & 3) + ((x >> 4) << 2) + (x & 3); }
__device__ __forceinline__ float wave_sum(float v) {
#pragma unroll
    for (int o = 1; o < 64; o <<= 1) v += __shfl_xor(v, o);
    return v;
}

struct Frame {
    LAS unsigned char* lds;
    volatile LAS unsigned* MISC;
    gu32* ctl;
    int tid, lane, wave;
    int vcu, G;
    const float *xp, *xs, *cache_k, *cache_v, *state_delta, *state_conv, *norm1_g, *w_in, *conv_w, *a_log, *dt_bias, *dng, *qng, *kng, *w_o, *norm2_g, *w_up, *w_down;
    float* out;
    unsigned char* ws;
};
#define WSP(T, off) ((T*)(F.ws + (off)))

__device__ __forceinline__ void p0_transpose_item(const float* W, int ldw, int col0, int K, bf16* WT, int row_off, LAS float* scr, int item, int nblk, int lane) {
    const int kb = item / nblk, nb = item % nblk, k0 = 64 * kb, n0 = 32 * nb;
#pragma unroll 8
    for (int i = 0; i < 32; ++i) { const int kk = 2 * i + (lane >> 5); scr[kk * 33 + (lane & 31)] = W[(size_t)(k0 + kk) * ldw + col0 + n0 + (lane & 31)]; }
    LDS_WAIT(); asm volatile("" ::: "memory");
    const int c = lane & 7;
#pragma unroll
    for (int j = 0; j < 4; ++j) { const int n = (lane >> 3) + 8 * j; const LAS float* s = scr + (8 * c) * 33 + n;
        v4u o; o.x = cvtpk(s[0 * 33], s[1 * 33]); o.y = cvtpk(s[2 * 33], s[3 * 33]); o.z = cvtpk(s[4 * 33], s[5 * 33]); o.w = cvtpk(s[6 * 33], s[7 * 33]);
        *(GAS v4u*)(WT + (size_t)(row_off + n0 + n) * K + k0 + 8 * c) = o; }
    LDS_WAIT(); asm volatile("" ::: "memory");
}
__device__ __forceinline__ void p0_prologue(Frame& F) {
    const int gw = F.vcu * NWAVES + F.wave, NGW = F.G * NWAVES;
    {
        LAS float* scr = (LAS float*)(F.lds + RING_OFF + F.wave * 16384);
        constexpr int I_A = 16 * 64, I_B = 16 * 48, I_O = 16 * 32, I_U = 16 * 128, I_D = 64 * 32;
        constexpr int NITEMS = I_A + I_B + I_O + I_U + I_D;
        for (int it = gw; it < NITEMS; it += NGW) {
            int r = it;
            if (r < I_A) { p0_transpose_item(F.w_in, PCOLS, 0, D, WSP(bf16, WS_WIN), 0, scr, r, 64, F.lane); continue; } r -= I_A;
            if (r < I_B) { p0_transpose_item(F.w_in, PCOLS, 2056, D, WSP(bf16, WS_WIN), 2048, scr, r, 48, F.lane); continue; } r -= I_B;
            if (r < I_O) { p0_transpose_item(F.w_o, D, 0, D, WSP(bf16, WS_WO), 0, scr, r, 32, F.lane); continue; } r -= I_O;
            if (r < I_U) { p0_transpose_item(F.w_up, FF, 0, D, WSP(bf16, WS_WUP), 0, scr, r, 128, F.lane); continue; } r -= I_U;
            p0_transpose_item(F.w_down, D, 0, FF, WSP(bf16, WS_WDN), 0, scr, r, 32, F.lane);
        }
    }
    __syncthreads();
    {
        LAS float* wba = (LAS float*)(F.lds + RING_OFF);
        for (int i = F.tid; i < 1024 * 2; i += NWAVES * 64) { const int k = i >> 1, hh = i & 1; const f32x4 w = *(const f32x4*)(F.w_in + (size_t)k * PCOLS + 2048 + hh * 4);
            wba[(hh * 4 + 0) * 1024 + k] = w.x; wba[(hh * 4 + 1) * 1024 + k] = w.y; wba[(hh * 4 + 2) * 1024 + k] = w.z; wba[(hh * 4 + 3) * 1024 + k] = w.w; }
        __syncthreads();
        f32x4 g1[4];
#pragma unroll
        for (int j = 0; j < 4; ++j) g1[j] = *((const f32x4*)F.norm1_g + F.lane + 64 * j);
        for (int m = gw; m < M; m += NGW) {
            const float* xrow = (m < MP) ? F.xp + (size_t)m * D : F.xs + (size_t)(m - MP) * D;
            const GAS f32x4* xr = (const GAS f32x4*)xrow + F.lane;
            f32x4 v[4]; float s = 0.f;
#pragma unroll
            for (int j = 0; j < 4; ++j) { v[j] = xr[64 * j]; s += (v[j].x * v[j].x + v[j].y * v[j].y) + (v[j].z * v[j].z + v[j].w * v[j].w); }
            const float rstd = 1.f / sqrtf(wave_sum(s) * (1.f / D) + EPS);
            float dots[8];
#pragma unroll
            for (int e = 0; e < 8; ++e) dots[e] = 0.f;
            GAS unsigned long long* o8 = (GAS unsigned long long*)(WSP(bf16, WS_XN) + (size_t)m * D) + F.lane;
#pragma unroll
            for (int j = 0; j < 4; ++j) { v[j] = v[j] * rstd * g1[j];
                o8[64 * j] = (unsigned long long)cvtpk(v[j].x, v[j].y) | ((unsigned long long)cvtpk(v[j].z, v[j].w) << 32);
#pragma unroll
                for (int e = 0; e < 8; ++e) { const f32x4 w = *(const LAS f32x4*)(wba + e * 1024 + 4 * F.lane + 256 * j); dots[e] += (v[j].x * w.x + v[j].y * w.y) + (v[j].z * w.z + v[j].w * w.w); } }
#pragma unroll
            for (int e = 0; e < 8; ++e) dots[e] = wave_sum(dots[e]);
            if (F.lane < 4) {
                float bsel = dots[0], asel = dots[4];
                if (F.lane == 1) { bsel = dots[1]; asel = dots[5]; } else if (F.lane == 2) { bsel = dots[2]; asel = dots[6]; } else if (F.lane == 3) { bsel = dots[3]; asel = dots[7]; }
                const float beta = 1.f / (1.f + expf(-bsel));
                const float xx = asel + F.dt_bias[F.lane];
                const float sp = (xx > 20.f) ? xx : log1pf(expf(xx));
                WSP(float, WS_BETA)[(size_t)m * 4 + F.lane] = beta;
                WSP(float, WS_GG)[(size_t)m * 4 + F.lane] = -expf(F.a_log[F.lane]) * sp;
            }
        }
    }
}

__device__ __forceinline__ void p2_token_prep(Frame& F) {
    const int gw = F.vcu * NWAVES + F.wave, NGW = F.G * NWAVES, lane = F.lane;
    const bf16* PROJ = WSP(bf16, WS_PROJ);
    for (int seg = gw; seg < MP / 8 + NSB; seg += NGW) {
        const bool smp = seg >= MP / 8;
        const int b = seg >> 9, t0 = smp ? 0 : (seg & 511) * 8, s = seg - MP / 8;
        const int row0 = smp ? MP + s * 8 : b * SEQ + t0;
        const int hA = lane >> 4, dim8 = (lane & 15) * 8, bh = b * HA + hA;
#pragma unroll 1
        for (int j = 0; j < 3; ++j) {
            const int col8 = (lane + 64 * j) * 8;
            float cw[4][8];
#pragma unroll
            for (int i = 0; i < 4; ++i) { const f32x4 a = *(const f32x4*)(F.conv_w + i * CONVC + col8), c = *(const f32x4*)(F.conv_w + i * CONVC + col8 + 4);
                cw[i][0] = a.x; cw[i][1] = a.y; cw[i][2] = a.z; cw[i][3] = a.w; cw[i][4] = c.x; cw[i][5] = c.y; cw[i][6] = c.z; cw[i][7] = c.w; }
            float win[3][8];
#pragma unroll
            for (int i = 0; i < 3; ++i) {
                if (smp) { const f32x4 a = *(const f32x4*)(F.state_conv + ((size_t)s * 3 + i) * CONVC + col8), c = *(const f32x4*)(F.state_conv + ((size_t)s * 3 + i) * CONVC + col8 + 4);
                    win[i][0] = a.x; win[i][1] = a.y; win[i][2] = a.z; win[i][3] = a.w; win[i][4] = c.x; win[i][5] = c.y; win[i][6] = c.z; win[i][7] = c.w; }
                else if (t0 == 0) {
#pragma unroll
                    for (int e = 0; e < 8; ++e) win[i][e] = 0.f; }
                else { const v4u w = *(const GAS v4u*)(PROJ + (size_t)(row0 - 3 + i) * NPROJ + col8); unpack8(w, win[i]); }
            }
            unsigned tp[8][4];
            float prev[8];
#pragma unroll
            for (int tt = 0; tt < 8; ++tt) {
                float xn[8], y[8];
                { const v4u w = *(const GAS v4u*)(PROJ + (size_t)(row0 + tt) * NPROJ + col8); unpack8(w, xn); }
                float ss = 0.f;
#pragma unroll
                for (int e = 0; e < 8; ++e) { const float a = cw[0][e] * win[0][e] + cw[1][e] * win[1][e] + cw[2][e] * win[2][e] + cw[3][e] * xn[e]; y[e] = silu_f(a); ss += y[e] * y[e];
                    win[0][e] = win[1][e]; win[1][e] = win[2][e]; win[2][e] = xn[e]; }
                if (j < 2) {
                    ss += __shfl_xor(ss, 1); ss += __shfl_xor(ss, 2); ss += __shfl_xor(ss, 4); ss += __shfl_xor(ss, 8);
                    const float r = (1.f / sqrtf(ss + EPS)) * (j == 0 ? 0.08838834764831845f : 1.f);
#pragma unroll
                    for (int e = 0; e < 8; ++e) y[e] *= r;
                }
                if (tt >= 5 && (smp || t0 == SEQ - 8)) {
                    float* o = F.out + (smp ? O_CS + ((size_t)s * 3 + (tt - 5)) * CONVC : O_CP + ((size_t)b * 3 + (tt - 5)) * CONVC) + col8;
                    *(f32x4*)o = (f32x4){xn[0], xn[1], xn[2], xn[3]}; *(f32x4*)(o + 4) = (f32x4){xn[4], xn[5], xn[6], xn[7]};
                }
                if (smp) {
                    float* o = WSP(float, WS_QKVS) + (size_t)(s * 8 + tt) * CONVC + col8;
                    *(f32x4*)o = (f32x4){y[0], y[1], y[2], y[3]}; *(f32x4*)(o + 4) = (f32x4){y[4], y[5], y[6], y[7]};
                } else {
                    if (j < 2) *(GAS v4u*)(WSP(bf16, j == 0 ? WS_QA : WS_KA) + ((size_t)bh * SEQ + t0 + tt) * DA + dim8) = pack8(y);
                    if (j >= 1) {
                        if (tt & 1) {
#pragma unroll
                            for (int e = 0; e < 8; ++e) tp[e][tt >> 1] = cvtpk(prev[e], y[e]);
                        } else {
#pragma unroll
                            for (int e = 0; e < 8; ++e) prev[e] = y[e];
                        }
                    }
                }
            }
            if (!smp && j >= 1) {
                bf16* T = WSP(bf16, j == 1 ? WS_KAT : WS_VAT);
                const int grp = t0 >> 5, pa = perm_tok(t0 & 31), pb = perm_tok((t0 & 31) + 4);
#pragma unroll
                for (int e = 0; e < 8; ++e) { bf16* base = T + (((size_t)bh * DA + dim8 + e) * (SEQ / 32) + grp) * 32;
                    *(GAS u32x2v*)(base + pa) = (u32x2v){tp[e][0], tp[e][1]}; *(GAS u32x2v*)(base + pb) = (u32x2v){tp[e][2], tp[e][3]}; }
            }
        }
        {
            const int hb = lane >> 3, d8 = (lane & 7) * 8, col8b = lane * 8;
            float qg[8], kg[8];
            { const f32x4 a = *(const f32x4*)(F.qng + d8), c = *(const f32x4*)(F.qng + d8 + 4), e2 = *(const f32x4*)(F.kng + d8), f2 = *(const f32x4*)(F.kng + d8 + 4);
              qg[0] = a.x; qg[1] = a.y; qg[2] = a.z; qg[3] = a.w; qg[4] = c.x; qg[5] = c.y; qg[6] = c.z; qg[7] = c.w; kg[0] = e2.x; kg[1] = e2.y; kg[2] = e2.z; kg[3] = e2.w; kg[4] = f2.x; kg[5] = f2.y; kg[6] = f2.z; kg[7] = f2.w; }
#pragma unroll 2
            for (int tt = 0; tt < 8; ++tt) {
                const size_t prow = (size_t)(row0 + tt) * NPROJ;
                float q[8], k[8], v[8];
                { const v4u w = *(const GAS v4u*)(PROJ + prow + PC_QB + col8b); unpack8(w, q); }
                { const v4u w = *(const GAS v4u*)(PROJ + prow + PC_KB + col8b); unpack8(w, k); }
                { const v4u w = *(const GAS v4u*)(PROJ + prow + PC_VB + col8b); unpack8(w, v); }
                float sq = 0.f, sk = 0.f;
#pragma unroll
                for (int e = 0; e < 8; ++e) { sq += q[e] * q[e]; sk += k[e] * k[e]; }
                sq += __shfl_xor(sq, 1); sq += __shfl_xor(sq, 2); sq += __shfl_xor(sq, 4);
                sk += __shfl_xor(sk, 1); sk += __shfl_xor(sk, 2); sk += __shfl_xor(sk, 4);
                const float rq = (1.f / sqrtf(sq * (1.f / DB) + EPS)) * QB_SCALE, rk = 1.f / sqrtf(sk * (1.f / DB) + EPS);
#pragma unroll
                for (int e = 0; e < 8; ++e) { q[e] *= rq * qg[e]; k[e] *= rk * kg[e]; }
                if (smp) {
                    const size_t o = ((size_t)(s * 8 + tt) * HB + hb) * DB + d8;
                    float* qo = WSP(float, WS_QSB) + o; *(f32x4*)qo = (f32x4){q[0], q[1], q[2], q[3]}; *(f32x4*)(qo + 4) = (f32x4){q[4], q[5], q[6], q[7]};
                    float* ko = F.out + O_KS + o; *(f32x4*)ko = (f32x4){k[0], k[1], k[2], k[3]}; *(f32x4*)(ko + 4) = (f32x4){k[4], k[5], k[6], k[7]};
                    float* vo = F.out + O_VS + o; *(f32x4*)vo = (f32x4){v[0], v[1], v[2], v[3]}; *(f32x4*)(vo + 4) = (f32x4){v[4], v[5], v[6], v[7]};
                } else {
                    const int t = t0 + tt, c16 = t & 15, i16 = t >> 4;
                    const size_t qi = ((((size_t)b * HB + hb) * 16 + c16) * 256 + i16) * DB + d8;
                    *(GAS v4u*)(WSP(bf16, WS_Q16) + qi) = pack8(q);
                    *(GAS v4u*)(WSP(bf16, WS_K16) + qi) = pack8(k);
                    bf16* vt = WSP(bf16, WS_VT16) + ((((size_t)b * HB + hb) * 16 + c16) * 8 + (i16 >> 5)) * (DB * 32) + perm_tok(i16 & 31);
                    const v4u vp = pack8(v);
#pragma unroll
                    for (int e = 0; e < 8; ++e) { const unsigned w = (e < 2) ? vp.x : (e < 4) ? vp.y : (e < 6) ? vp.z : vp.w; vt[(d8 + e) * 32] = (bf16)((e & 1) ? (w >> 16) : (w & 0xffffu)); }
                    if (t >= SEQ - WBUF) {
                        const size_t o = (((size_t)b * WBUF + (t - (SEQ - WBUF))) * HB + hb) * DB + d8;
                        float* ko = F.out + O_KP + o; *(f32x4*)ko = (f32x4){k[0], k[1], k[2], k[3]}; *(f32x4*)(ko + 4) = (f32x4){k[4], k[5], k[6], k[7]};
                        float* vo = F.out + O_VP + o; *(f32x4*)vo = (f32x4){v[0], v[1], v[2], v[3]}; *(f32x4*)(vo + 4) = (f32x4){v[4], v[5], v[6], v[7]};
                    }
                }
            }
        }
    }
}

constexpr int P3_GC = 0, P3_BETA = 256, P3_LM = 512, P3_TB = P3_LM + 64 * 64 * 4, TPITCH = 72, P3_TG = P3_TB + 64 * TPITCH * 2, P3_END = P3_TG + 64 * TPITCH * 2;
__device__ __forceinline__ void p3_chunk_prep(Frame& F) {
    LAS float* Gc = (LAS float*)(F.lds + P3_GC); LAS float* Bt = (LAS float*)(F.lds + P3_BETA); LAS float* Lm = (LAS float*)(F.lds + P3_LM);
    LAS bf16* TB = (LAS bf16*)(F.lds + P3_TB); LAS bf16* TG = (LAS bf16*)(F.lds + P3_TG);
    const int lane = F.lane, wave = F.wave, fr = lane & 15, fq = lane >> 4;
    const bf16* QA = WSP(bf16, WS_QA); const bf16* KA = WSP(bf16, WS_KA); const bf16* KAT = WSP(bf16, WS_KAT); const bf16* VAT = WSP(bf16, WS_VAT);
    for (int unit = F.vcu; unit < NBH * NCH; unit += F.G) {
        const int bh = unit >> 6, n = unit & 63, b = bh >> 2, h = bh & 3, t0 = n * 64;
        if (wave == 0) {
            const size_t r = (size_t)(b * SEQ + t0 + lane) * 4 + h;
            float g = WSP(float, WS_GG)[r];
#pragma unroll
            for (int o = 1; o < 64; o <<= 1) { const float up = __shfl_up(g, o); if (lane >= o) g += up; }
            Gc[lane] = g; Bt[lane] = WSP(float, WS_BETA)[r];
            WSP(float, WS_GC)[(size_t)bh * SEQ + t0 + lane] = g;
        }
        __syncthreads();
#pragma unroll 1
        for (int tl = wave; tl < 32; tl += NWAVES) {
            const int which = tl >> 4, it = (tl >> 2) & 3, jt = tl & 3;
            f32x4 acc = (f32x4){0.f, 0.f, 0.f, 0.f};
            if (jt <= it) {
                const bf16* Ap = (which ? QA : KA) + ((size_t)bh * SEQ + t0 + 16 * it + fr) * DA + 8 * fq;
                const bf16* Bp = KA + ((size_t)bh * SEQ + t0 + 16 * jt + fr) * DA + 8 * fq;
#pragma unroll
                for (int ks = 0; ks < 4; ++ks) { const v4u a = *(const GAS v4u*)(Ap + 32 * ks), bb = *(const GAS v4u*)(Bp + 32 * ks); acc = mfma16(as_bf16x8(a), as_bf16x8(bb), acc); }
            }
            const int j = 16 * jt + fr; const float gj = Gc[j];
#pragma unroll
            for (int r = 0; r < 4; ++r) {
                const int i = 16 * it + 4 * fq + r; const float dec = __expf(Gc[i] - gj);
                if (which == 0) { if (jt <= it) Lm[i * 64 + j] = (i > j) ? acc[r] * Bt[i] * dec : 0.f; }
                else { const float val = (i >= j) ? acc[r] * dec : 0.f;
                    const int ksc = j >> 5, jp = j & 31, gq = (jp >> 2) & 3, jj = ((jp >> 4) << 2) | (jp & 3), lt = (gq << 4) | (i & 15);
                    WSP(bf16, WS_QKF)[((((size_t)bh * NCH + n) * 4 + it) * 2 + ksc) * 512 + lt * 8 + jj] = (bf16)(cvtpk(val, 0.f) & 0xffffu); }
            }
        }
        __syncthreads();
        if (wave == 0) {
            float x[64];
#pragma unroll
            for (int i = 0; i < 64; ++i) {
                float a = (i == lane) ? 1.f : 0.f;
#pragma unroll
                for (int j4 = 0; j4 < (i + 3) / 4; ++j4) { const f32x4 l = *(const LAS f32x4*)(Lm + i * 64 + 4 * j4);
                    if (4 * j4 + 0 < i) a -= l.x * x[4 * j4 + 0]; if (4 * j4 + 1 < i) a -= l.y * x[4 * j4 + 1]; if (4 * j4 + 2 < i) a -= l.z * x[4 * j4 + 2]; if (4 * j4 + 3 < i) a -= l.w * x[4 * j4 + 3]; }
                x[i] = a;
            }
            const float bc = Bt[lane], bg = bc * __expf(Gc[lane]);
#pragma unroll
            for (int i = 0; i < 64; i += 1) { TB[i * TPITCH + lane] = (bf16)(cvtpk(x[i] * bc, 0.f) & 0xffffu); TG[i * TPITCH + lane] = (bf16)(cvtpk(x[i] * bg, 0.f) & 0xffffu); }
        }
        __syncthreads();
#pragma unroll 1
        for (int tl = wave; tl < 64; tl += NWAVES) {
            f32x4 acc = (f32x4){0.f, 0.f, 0.f, 0.f};
            if (tl < 32) {
                const int ct = tl >> 3, vt = tl & 7;
#pragma unroll
                for (int ks = 0; ks < 2; ++ks) {
                    const LAS bf16* tp = TB + (16 * ct + fr) * TPITCH + 32 * ks + 4 * fq;
                    const u32x2v a0 = *(const LAS u32x2v*)tp, a1 = *(const LAS u32x2v*)(tp + 16);
                    const v4u bb = *(const GAS v4u*)(VAT + (((size_t)bh * DA + 16 * vt + fr) * (SEQ / 32) + 2 * n + ks) * 32 + 8 * fq);
                    acc = mfma16(as_bf16x8((v4u){a0.x, a0.y, a1.x, a1.y}), as_bf16x8(bb), acc);
                }
                *(GAS f32x4*)(WSP(float, WS_UF) + (((((size_t)bh * NCH + n) * 8 + vt) * 4 + ct) * 64 + lane) * 4) = acc;
            } else {
                const int kt = (tl - 32) >> 2, ct = tl & 3;
#pragma unroll
                for (int ks = 0; ks < 2; ++ks) {
                    const v4u a = *(const GAS v4u*)(KAT + (((size_t)bh * DA + 16 * kt + fr) * (SEQ / 32) + 2 * n + ks) * 32 + 8 * fq);
                    const LAS bf16* tp = TG + (16 * ct + fr) * TPITCH + 32 * ks + 4 * fq;
                    const u32x2v b0 = *(const LAS u32x2v*)tp, b1 = *(const LAS u32x2v*)(tp + 16);
                    acc = mfma16(as_bf16x8(a), as_bf16x8((v4u){b0.x, b0.y, b1.x, b1.y}), acc);
                }
                *(GAS u32x2v*)(WSP(bf16, WS_WF) + (((((size_t)bh * NCH + n) * 4 + ct) * 4 + (kt >> 1)) * 64 + lane) * 8 + (kt & 1) * 4) = (u32x2v){cvtpk(acc[0], acc[1]), cvtpk(acc[2], acc[3])};
            }
        }
        __syncthreads();
    }
}

constexpr int P4_SB = 0, P4_VN = 8192, P4_END = 8192 + 8192;
struct ScanOps { v4u wf[4]; u32x2v qf[4][2]; v4u qk[2]; f32x4 u; v4u kf[2][2]; f32x4 gc; float gl; };
#define GLD(T, sbase, voff, imm) (*(const GAS T*)((const GAS unsigned char*)(sbase) + (voff) + (imm)))
__device__ __forceinline__ void p4_scan_load(Frame& F, ScanOps& o, int bh, int n, int vt, int ct, int lane) {
    const unsigned fr = lane & 15, fq = lane >> 4; const size_t cb = (size_t)bh * NCH + n;
    const unsigned char* wb = F.ws + WS_WF + ((cb * 4 + ct) * 4) * 1024;
    const unsigned char* qb = F.ws + WS_QA + ((size_t)bh * SEQ + 64 * n + 16 * ct) * DA * 2;
    const unsigned char* qkb = F.ws + WS_QKF + ((cb * 4 + ct) * 2) * 1024;
    const unsigned char* kb0 = F.ws + WS_KAT + (((size_t)bh * DA + 32 * ct) * (SEQ / 32) + 2 * n) * 64;
    const unsigned char* kb1 = kb0 + (size_t)16 * (SEQ / 32) * 64;
    const unsigned char* ub = F.ws + WS_UF + (((cb * 8 + vt) * 4 + ct) * 64) * 16;
    const unsigned char* gb = F.ws + WS_GC + ((size_t)bh * SEQ + 64 * n + 16 * ct) * 4;
    const unsigned l16 = lane * 16u, qoff = (fr * DA + 4 * fq) * 2u, koff = fr * (SEQ / 32) * 64u + fq * 16u;
#pragma unroll
    for (int ks = 0; ks < 4; ++ks) { o.wf[ks] = GLD(v4u, wb, l16, ks * 1024); o.qf[ks][0] = GLD(u32x2v, qb, qoff, ks * 64); o.qf[ks][1] = GLD(u32x2v, qb, qoff, ks * 64 + 32); }
#pragma unroll
    for (int ks = 0; ks < 2; ++ks) { o.qk[ks] = GLD(v4u, qkb, l16, ks * 1024); o.kf[0][ks] = GLD(v4u, kb0, koff, ks * 64); o.kf[1][ks] = GLD(v4u, kb1, koff, ks * 64); }
    o.u = GLD(f32x4, ub, l16, 0);
    o.gc = GLD(f32x4, gb, fq * 16u, 0);
    o.gl = *(const float*)(gb + (63 - 16 * ct) * 4);
}
__device__ __forceinline__ void p4_scan_step(Frame& F, const ScanOps& cur, f32x4 (&S)[2], LAS unsigned char* SB, LAS unsigned char* VN, int n, int b, int h, int vt, int ct, int lane) {
    const int fr = lane & 15, fq = lane >> 4;
#pragma unroll
    for (int ki = 0; ki < 2; ++ki) *(LAS u32x2v*)(SB + (ct * 64 + lane) * 16 + ki * 8) = (u32x2v){cvtpk(S[ki][0], S[ki][1]), cvtpk(S[ki][2], S[ki][3])};
    __syncthreads();
    f32x4 t1 = (f32x4){0.f, 0.f, 0.f, 0.f}, o1 = (f32x4){0.f, 0.f, 0.f, 0.f};
#pragma unroll
    for (int ks = 0; ks < 4; ++ks) { const bf16x8 sb = as_bf16x8(*(const LAS v4u*)(SB + (ks * 64 + lane) * 16));
        t1 = mfma16(as_bf16x8(cur.wf[ks]), sb, t1);
        o1 = mfma16(as_bf16x8((v4u){cur.qf[ks][0].x, cur.qf[ks][0].y, cur.qf[ks][1].x, cur.qf[ks][1].y}), sb, o1); }
    f32x4 vn, vs;
#pragma unroll
    for (int r = 0; r < 4; ++r) { vn[r] = cur.u[r] - t1[r]; vs[r] = vn[r] * __expf(cur.gl - cur.gc[r]); }
    *(LAS u32x2v*)(VN + ((0 * 2 + (ct >> 1)) * 64 + lane) * 16 + (ct & 1) * 8) = (u32x2v){cvtpk(vn[0], vn[1]), cvtpk(vn[2], vn[3])};
    *(LAS u32x2v*)(VN + ((1 * 2 + (ct >> 1)) * 64 + lane) * 16 + (ct & 1) * 8) = (u32x2v){cvtpk(vs[0], vs[1]), cvtpk(vs[2], vs[3])};
    __syncthreads();
    f32x4 o2 = (f32x4){0.f, 0.f, 0.f, 0.f};
    const float egl = __expf(cur.gl);
    S[0] = S[0] * egl; S[1] = S[1] * egl;
#pragma unroll
    for (int ks = 0; ks < 2; ++ks) { const bf16x8 vnb = as_bf16x8(*(const LAS v4u*)(VN + ((0 * 2 + ks) * 64 + lane) * 16)), vsb = as_bf16x8(*(const LAS v4u*)(VN + ((1 * 2 + ks) * 64 + lane) * 16));
        o2 = mfma16(as_bf16x8(cur.qk[ks]), vnb, o2);
        S[0] = mfma16(as_bf16x8(cur.kf[0][ks]), vsb, S[0]); S[1] = mfma16(as_bf16x8(cur.kf[1][ks]), vsb, S[1]); }
    float* oa = WSP(float, WS_OA) + (size_t)(b * SEQ + 64 * n + 16 * ct + 4 * fq) * WA + h * DA + 16 * vt + fr;
#pragma unroll
    for (int r = 0; r < 4; ++r) oa[(size_t)r * WA] = __expf(cur.gc[r]) * o1[r] + o2[r];
}
__device__ __forceinline__ void p4_scan(Frame& F, int unit) {
    const int lane = F.lane, wave = F.wave, fr = lane & 15, fq = lane >> 4;
    const int bh = unit >> 2, vq = unit & 3, vtl = wave >> 2, ct = wave & 3, vt = 2 * vq + vtl, b = bh >> 2, h = bh & 3;
    LAS unsigned char* SB = F.lds + P4_SB + vtl * 4096;
    LAS unsigned char* VN = F.lds + P4_VN + vtl * 4096;
    f32x4 S[2] = {(f32x4){0.f, 0.f, 0.f, 0.f}, (f32x4){0.f, 0.f, 0.f, 0.f}};
    ScanOps A, B;
    p4_scan_load(F, A, bh, 0, vt, ct, lane);
#pragma unroll 1
    for (int n = 0; n < NCH; n += 2) {
        p4_scan_load(F, B, bh, n + 1, vt, ct, lane);
        p4_scan_step(F, A, S, SB, VN, n, b, h, vt, ct, lane);
        p4_scan_load(F, A, bh, (n + 2 < NCH) ? n + 2 : n, vt, ct, lane);
        p4_scan_step(F, B, S, SB, VN, n + 1, b, h, vt, ct, lane);
    }
#pragma unroll
    for (int ki = 0; ki < 2; ++ki)
#pragma unroll
        for (int r = 0; r < 4; ++r) F.out[O_DP + ((size_t)bh * DA + 16 * (2 * ct + ki) + 4 * fq + r) * DA + 16 * vt + fr] = S[ki][r];
    __syncthreads();
}

constexpr int P4B_QKV = 16384, P4B_RED = P4B_QKV + 8 * 3 * 128 * 4, P4B_SC = P4B_RED + 2 * 4 * 128 * 4;
__device__ __forceinline__ void p4b_sample_delta(Frame& F, int unit) {
    const int tid = F.tid, s = unit >> 2, h = unit & 3, kq = tid >> 7, v = tid & 127;
    LAS float* qkv = (LAS float*)(F.lds + P4B_QKV); LAS float* red = (LAS float*)(F.lds + P4B_RED); LAS float* sc = (LAS float*)(F.lds + P4B_SC);
    for (int i = tid; i < 8 * 3 * 128; i += NWAVES * 64) { const int t = i / 384, r = i % 384, th = r >> 7, d = r & 127; qkv[i] = WSP(float, WS_QKVS)[(size_t)(s * 8 + t) * CONVC + th * 512 + h * DA + d]; }
    if (tid < 16) { const int t = tid & 7; const size_t r = (size_t)(MP + s * 8 + t) * 4 + h; sc[tid] = (tid < 8) ? WSP(float, WS_BETA)[r] : __expf(WSP(float, WS_GG)[r]); }
    float S[32];
    const float* sp = F.state_delta + ((size_t)(s * HA + h) * DA + 32 * kq) * DA + v;
#pragma unroll
    for (int i = 0; i < 32; ++i) S[i] = sp[(size_t)i * DA];
    __syncthreads();
#pragma unroll 1
    for (int t = 0; t < 8; ++t) {
        const LAS float* qt = qkv + t * 384 + 32 * kq; const LAS float* kt = qt + 128; const float beta = sc[t], dec = sc[8 + t];
        float part = 0.f;
#pragma unroll
        for (int i = 0; i < 32; ++i) { S[i] *= dec; part += kt[i] * S[i]; }
        red[kq * 128 + v] = part;
        __syncthreads();
        const float ks = (red[v] + red[128 + v]) + (red[256 + v] + red[384 + v]);
        const float vn = beta * (qkv[t * 384 + 256 + v] - ks);
        float po = 0.f;
#pragma unroll
        for (int i = 0; i < 32; ++i) { S[i] += kt[i] * vn; po += qt[i] * S[i]; }
        red[512 + kq * 128 + v] = po;
        __syncthreads();
        if (kq == 0) WSP(float, WS_OA)[(size_t)(MP + s * 8 + t) * WA + h * DA + v] = (red[512 + v] + red[640 + v]) + (red[768 + v] + red[896 + v]);
    }
    float* dp = F.out + O_DS + ((size_t)(s * HA + h) * DA + 32 * kq) * DA + v;
#pragma unroll
    for (int i = 0; i < 32; ++i) dp[(size_t)i * DA] = S[i];
    __syncthreads();
}

__device__ __forceinline__ void p4c_attn_prompt(Frame& F, int job) {
    const int lane = F.lane, fr = lane & 15, fq = lane >> 4;
    const int qb = job & 3, c0 = (job >> 2) & 15, hb = (job >> 6) & 7, b = job >> 9, i0 = 64 * qb;
    const size_t hbase = (size_t)b * HB + hb;
    const bf16* Q16 = WSP(bf16, WS_Q16) + ((hbase * 16 + c0) * 256) * DB;
    v4u qf[4][2];
#pragma unroll
    for (int qs = 0; qs < 4; ++qs)
#pragma unroll
        for (int ks = 0; ks < 2; ++ks) qf[qs][ks] = *(const GAS v4u*)(Q16 + (size_t)(i0 + 16 * qs + fr) * DB + 32 * ks + 8 * fq);
    f32x4 O[4][4]; float mrow[4], lrow[4];
#pragma unroll
    for (int qs = 0; qs < 4; ++qs) { mrow[qs] = -1e30f; lrow[qs] = 0.f;
#pragma unroll
        for (int dt = 0; dt < 4; ++dt) O[qs][dt] = (f32x4){0.f, 0.f, 0.f, 0.f}; }
#pragma unroll 1
    for (int c = 0; c < 16; ++c) {
        const int dc = c0 - c;
        const int wmax = (dc == 0) ? 2048 : ((dc & 3) == 0 ? 512 : 128);
        const int span = (wmax - dc) >> 4;
        const int lag = (dc < 0) ? 1 : 0;
        int ikmin = i0 - span; if (ikmin < 0) ikmin = 0;
        const int ikmax = i0 + 63 - lag;
        const bf16* K16 = WSP(bf16, WS_K16) + ((hbase * 16 + c) * 256) * DB;
        const bf16* VT = WSP(bf16, WS_VT16) + ((hbase * 16 + c) * 8) * (DB * 32);
#pragma unroll 1
        for (int kc = ikmin >> 5; kc <= (ikmax >> 5); ++kc) {
            v4u kf[2][2], vf[4];
#pragma unroll
            for (int kt = 0; kt < 2; ++kt)
#pragma unroll
                for (int ks = 0; ks < 2; ++ks) kf[kt][ks] = *(const GAS v4u*)(K16 + (size_t)(32 * kc + 16 * kt + fr) * DB + 32 * ks + 8 * fq);
#pragma unroll
            for (int dt = 0; dt < 4; ++dt) vf[dt] = *(const GAS v4u*)(VT + ((size_t)kc * DB + 16 * dt + fr) * 32 + 8 * fq);
#pragma unroll
            for (int qs = 0; qs < 4; ++qs) {
                const int iqlo = i0 + 16 * qs, iqhi = iqlo + 15;
                if (32 * kc > iqhi - lag || 32 * kc + 31 < iqlo - span) continue;
                f32x4 s0 = (f32x4){0.f, 0.f, 0.f, 0.f}, s1 = s0;
#pragma unroll
                for (int ks = 0; ks < 2; ++ks) { s0 = mfma16(as_bf16x8(kf[0][ks]), as_bf16x8(qf[qs][ks]), s0); s1 = mfma16(as_bf16x8(kf[1][ks]), as_bf16x8(qf[qs][ks]), s1); }
                const int iq = iqlo + fr;
                float cn[8], sv[8]; float mx = mrow[qs];
#pragma unroll
                for (int e = 0; e < 8; ++e) {
                    const int ik = 32 * kc + 16 * (e >> 2) + 4 * fq + (e & 3);
                    const int dl = 16 * (iq - ik) + dc;
                    float cnt = 0.f;
                    if (dl >= 0) { if (dl <= 128) cnt += 1.f; if ((dc & 3) == 0 && dl <= 512) cnt += 1.f; if (dc == 0 && dl <= 2048) cnt += 1.f; }
                    cn[e] = cnt; const float sc = (e < 4) ? s0[e & 3] : s1[e & 3]; sv[e] = (cnt > 0.f) ? sc : -1e30f; mx = fmaxf(mx, sv[e]);
                }
                mx = fmaxf(mx, __shfl_xor(mx, 16)); mx = fmaxf(mx, __shfl_xor(mx, 32));
                const float alpha = exp2f(mrow[qs] - mx); mrow[qs] = mx;
                float p[8], ps = 0.f;
#pragma unroll
                for (int e = 0; e < 8; ++e) { p[e] = cn[e] * exp2f(sv[e] - mx); ps += p[e]; }
                ps += __shfl_xor(ps, 16); ps += __shfl_xor(ps, 32);
                lrow[qs] = lrow[qs] * alpha + ps;
                const bf16x8 pb = as_bf16x8((v4u){cvtpk(p[0], p[1]), cvtpk(p[2], p[3]), cvtpk(p[4], p[5]), cvtpk(p[6], p[7])});
#pragma unroll
                for (int dt = 0; dt < 4; ++dt) { O[qs][dt] = O[qs][dt] * alpha; O[qs][dt] = mfma16(as_bf16x8(vf[dt]), pb, O[qs][dt]); }
            }
        }
    }
#pragma unroll
    for (int qs = 0; qs < 4; ++qs) {
        const float inv = 1.f / lrow[qs];
        const int t = c0 + 16 * (i0 + 16 * qs + fr);
        bf16* o = WSP(bf16, WS_MIX) + (size_t)(b * SEQ + t) * D + WA + hb * DB + 4 * fq;
#pragma unroll
        for (int dt = 0; dt < 4; ++dt) *(GAS u32x2v*)(o + 16 * dt) = (u32x2v){cvtpk(O[qs][dt][0] * inv, O[qs][dt][1] * inv), cvtpk(O[qs][dt][2] * inv, O[qs][dt][3] * inv)};
    }
}

constexpr int P4D_PART = 32768;
__device__ __forceinline__ void p4d_rowptr(Frame& F, int s, int ch, int kk, const float*& kp, const float*& vp, int& pos) {
    if (ch < 24) { const int rho = 64 * ch + 16 * (kk >> 3) + (kk & 7); pos = rho; kp = F.cache_k + ((size_t)s * WBUF + rho) * WB; vp = F.cache_v + ((size_t)s * WBUF + rho) * WB; }
    else if (ch < 40) { const int rho = 1536 + 32 * (ch - 24) + kk; pos = rho; kp = F.cache_k + ((size_t)s * WBUF + rho) * WB; vp = F.cache_v + ((size_t)s * WBUF + rho) * WB; }
    else { const int tq = kk & 7; pos = (kk < 8) ? WBUF + tq : 1 << 20; kp = F.out + O_KS + (size_t)(s * 8 + tq) * WB; vp = F.out + O_VS + (size_t)(s * 8 + tq) * WB; }
}
__device__ __forceinline__ void p4d_attn_sample(Frame& F, int unit) {
    const int lane = F.lane, wave = F.wave, fr = lane & 15, fq = lane >> 4;
    const int s = unit >> 2, hb = (unit & 3) * 2 + (wave >> 2), qtr = wave & 3;
    v4u qf[2];
#pragma unroll
    for (int ks = 0; ks < 2; ++ks) {
        if (fr < 8) { const float* qp = WSP(float, WS_QSB) + ((size_t)(s * 8 + fr) * HB + hb) * DB + 32 * ks + 8 * fq; const f32x4 a = *(const f32x4*)qp, c = *(const f32x4*)(qp + 4);
            qf[ks] = (v4u){cvtpk(a.x, a.y), cvtpk(a.z, a.w), cvtpk(c.x, c.y), cvtpk(c.z, c.w)}; }
        else qf[ks] = (v4u){0u, 0u, 0u, 0u};
    }
    f32x4 O[4]; float mrow = -1e30f, lrow = 0.f;
#pragma unroll
    for (int dt = 0; dt < 4; ++dt) O[dt] = (f32x4){0.f, 0.f, 0.f, 0.f};
#pragma unroll 1
    for (int ch = qtr; ch < 41; ch += 4) {
        f32x4 kr[2][2][2];
#pragma unroll
        for (int kt = 0; kt < 2; ++kt) { const float* kp; const float* vp; int pos; p4d_rowptr(F, s, ch, 16 * kt + fr, kp, vp, pos);
#pragma unroll
            for (int ks = 0; ks < 2; ++ks) { kr[kt][ks][0] = *(const f32x4*)(kp + hb * DB + 32 * ks + 8 * fq); kr[kt][ks][1] = *(const f32x4*)(kp + hb * DB + 32 * ks + 8 * fq + 4); } }
        float vr[4][8];
#pragma unroll
        for (int jj = 0; jj < 8; ++jj) { const float* kp; const float* vp; int pos; p4d_rowptr(F, s, ch, 16 * (jj >> 2) + 4 * fq + (jj & 3), kp, vp, pos);
#pragma unroll
            for (int dt = 0; dt < 4; ++dt) vr[dt][jj] = vp[hb * DB + 16 * dt + fr]; }
        f32x4 s0 = (f32x4){0.f, 0.f, 0.f, 0.f}, s1 = s0;
#pragma unroll
        for (int ks = 0; ks < 2; ++ks) {
            const v4u k0 = (v4u){cvtpk(kr[0][ks][0].x, kr[0][ks][0].y), cvtpk(kr[0][ks][0].z, kr[0][ks][0].w), cvtpk(kr[0][ks][1].x, kr[0][ks][1].y), cvtpk(kr[0][ks][1].z, kr[0][ks][1].w)};
            const v4u k1 = (v4u){cvtpk(kr[1][ks][0].x, kr[1][ks][0].y), cvtpk(kr[1][ks][0].z, kr[1][ks][0].w), cvtpk(kr[1][ks][1].x, kr[1][ks][1].y), cvtpk(kr[1][ks][1].z, kr[1][ks][1].w)};
            s0 = mfma16(as_bf16x8(k0), as_bf16x8(qf[ks]), s0); s1 = mfma16(as_bf16x8(k1), as_bf16x8(qf[ks]), s1);
        }
        const int qpos = WBUF + fr;
        float cn[8], sv[8]; float mx = mrow;
#pragma unroll
        for (int e = 0; e < 8; ++e) {
            const float* kp; const float* vp; int pos; p4d_rowptr(F, s, ch, 16 * (e >> 2) + 4 * fq + (e & 3), kp, vp, pos);
            const int dl = qpos - pos;
            float cnt = 0.f;
            if (dl >= 0 && fr < 8) { cnt = (dl <= 128) ? 1.f : 0.f; if ((dl & 3) == 0 && dl <= 512) cnt += 1.f; if ((dl & 15) == 0 && dl <= 2048) cnt += 1.f; }
            cn[e] = cnt; const float sc = (e < 4) ? s0[e & 3] : s1[e & 3]; sv[e] = (cnt > 0.f) ? sc : -1e30f; mx = fmaxf(mx, sv[e]);
        }
        mx = fmaxf(mx, __shfl_xor(mx, 16)); mx = fmaxf(mx, __shfl_xor(mx, 32));
        const float alpha = exp2f(mrow - mx); mrow = mx;
        float p[8], ps = 0.f;
#pragma unroll
        for (int e = 0; e < 8; ++e) { p[e] = cn[e] * exp2f(sv[e] - mx); ps += p[e]; }
        ps += __shfl_xor(ps, 16); ps += __shfl_xor(ps, 32);
        lrow = lrow * alpha + ps;
        const bf16x8 pb = as_bf16x8((v4u){cvtpk(p[0], p[1]), cvtpk(p[2], p[3]), cvtpk(p[4], p[5]), cvtpk(p[6], p[7])});
#pragma unroll
        for (int dt = 0; dt < 4; ++dt) { const v4u va = (v4u){cvtpk(vr[dt][0], vr[dt][1]), cvtpk(vr[dt][2], vr[dt][3]), cvtpk(vr[dt][4], vr[dt][5]), cvtpk(vr[dt][6], vr[dt][7])};
            O[dt] = O[dt] * alpha; O[dt] = mfma16(as_bf16x8(va), pb, O[dt]); }
    }
    LAS float* part = (LAS float*)(F.lds + P4D_PART);
    if (fr < 8) {
        LAS float* pp = part + (wave * 8 + fr) * 66;
#pragma unroll
        for (int dt = 0; dt < 4; ++dt)
#pragma unroll
            for (int r = 0; r < 4; ++r) pp[16 * dt + 4 * fq + r] = O[dt][r];
        if (fq == 0) { pp[64] = mrow; pp[65] = lrow; }
    }
    __syncthreads();
    for (int i = F.tid; i < 2 * 8 * 64; i += NWAVES * 64) {
        const int hh = i >> 9, q = (i >> 6) & 7, d = i & 63;
        float m = -1e30f;
#pragma unroll
        for (int w = 0; w < 4; ++w) m = fmaxf(m, part[((hh * 4 + w) * 8 + q) * 66 + 64]);
        float num = 0.f, den = 0.f;
#pragma unroll
        for (int w = 0; w < 4; ++w) { const LAS float* pp = part + ((hh * 4 + w) * 8 + q) * 66; const float sc = exp2f(pp[64] - m); num += sc * pp[d]; den += sc * pp[65]; }
        const int hq = (unit & 3) * 2 + hh;
        WSP(bf16, WS_MIX)[(size_t)(MP + s * 8 + q) * D + WA + hq * DB + d] = (bf16)(cvtpk(num / den, 0.f) & 0xffffu);
    }
    __syncthreads();
}

__device__ __forceinline__ void p5_gate(Frame& F) {
    const int gw = F.vcu * NWAVES + F.wave, NGW = F.G * NWAVES, lane = F.lane, col8 = lane * 8, dim8 = (lane & 15) * 8;
    float dg[8];
    { const f32x4 a = *(const f32x4*)(F.dng + dim8), c = *(const f32x4*)(F.dng + dim8 + 4); dg[0] = a.x; dg[1] = a.y; dg[2] = a.z; dg[3] = a.w; dg[4] = c.x; dg[5] = c.y; dg[6] = c.z; dg[7] = c.w; }
    for (int m = gw; m < M; m += NGW) {
        const float* op = WSP(float, WS_OA) + (size_t)m * WA + col8;
        const f32x4 a = *(const GAS f32x4*)op, c = *(const GAS f32x4*)(op + 4);
        float o[8] = {a.x, a.y, a.z, a.w, c.x, c.y, c.z, c.w}, z[8];
        { const v4u w = *(const GAS v4u*)(WSP(bf16, WS_PROJ) + (size_t)m * NPROJ + PC_Z + col8); unpack8(w, z); }
        float ss = 0.f;
#pragma unroll
        for (int e = 0; e < 8; ++e) ss += o[e] * o[e];
        ss += __shfl_xor(ss, 1); ss += __shfl_xor(ss, 2); ss += __shfl_xor(ss, 4); ss += __shfl_xor(ss, 8);
        const float r = 1.f / sqrtf(ss * (1.f / DA) + EPS);
#pragma unroll
        for (int e = 0; e < 8; ++e) o[e] = o[e] * r * dg[e] * silu_f(z[e]);
        *(GAS v4u*)(WSP(bf16, WS_MIX) + (size_t)m * D + col8) = pack8(o);
    }
}
__device__ __forceinline__ void p7_norm2(Frame& F) {
    const int gw = F.vcu * NWAVES + F.wave, NGW = F.G * NWAVES;
    f32x4 g2[4];
#pragma unroll
    for (int j = 0; j < 4; ++j) g2[j] = *((const f32x4*)F.norm2_g + F.lane + 64 * j);
    for (int m = gw; m < M; m += NGW) {
        const GAS f32x4* xr = (const GAS f32x4*)(F.out + (size_t)m * D) + F.lane;
        f32x4 v[4]; float s = 0.f;
#pragma unroll
        for (int j = 0; j < 4; ++j) { v[j] = xr[64 * j]; s += (v[j].x * v[j].x + v[j].y * v[j].y) + (v[j].z * v[j].z + v[j].w * v[j].w); }
        const float rstd = 1.f / sqrtf(wave_sum(s) * (1.f / D) + EPS);
        GAS unsigned long long* o8 = (GAS unsigned long long*)(WSP(bf16, WS_XN) + (size_t)m * D) + F.lane;
#pragma unroll
        for (int j = 0; j < 4; ++j) { v[j] = v[j] * rstd * g2[j]; o8[64 * j] = (unsigned long long)cvtpk(v[j].x, v[j].y) | ((unsigned long long)cvtpk(v[j].z, v[j].w) << 32); }
    }
}


constexpr int N_PHASES = 10;
#ifndef PH_LIMIT
#define PH_LIMIT 10
#endif
struct Args { const float* in[18]; float* out; unsigned char* ws; int ph_lo, ph_hi; };
__global__ void __launch_bounds__(NWAVES * 64, 2) hymba_fwd(Args args) {
    extern __shared__ __attribute__((aligned(16))) unsigned char lds[];
    Frame F;
    F.lds = (LAS unsigned char*)lds;
    F.MISC = (volatile LAS unsigned*)(F.lds + MISC_OFF);
    F.tid = threadIdx.x; F.lane = F.tid & 63; F.wave = __builtin_amdgcn_readfirstlane(F.tid >> 6);
    F.G = gridDim.x; { const int bx = blockIdx.x; F.vcu = (F.G % 8 == 0) ? (bx % 8) * (F.G / 8) + bx / 8 : bx; }
    F.ws = args.ws; F.out = args.out; F.ctl = (gu32*)(args.ws + WS_CTL);
    F.xp = args.in[0]; F.xs = args.in[1]; F.cache_k = args.in[2]; F.cache_v = args.in[3]; F.state_delta = args.in[4]; F.state_conv = args.in[5]; F.norm1_g = args.in[6]; F.w_in = args.in[7];
    F.conv_w = args.in[8]; F.a_log = args.in[9]; F.dt_bias = args.in[10]; F.dng = args.in[11]; F.qng = args.in[12]; F.kng = args.in[13]; F.w_o = args.in[14]; F.norm2_g = args.in[15]; F.w_up = args.in[16]; F.w_down = args.in[17];
    for (int u = F.tid; u < (LDS_BYTES - LDSCTL_OFF) / 4; u += NWAVES * 64) ((LAS unsigned*)(F.lds + LDSCTL_OFF))[u] = 0u;
    __syncthreads();
#if MK_ONE_LAUNCH
    XcdBarrier bar = xcd_barrier_post((unsigned*)(F.ctl + CW_BAR), F.MISC + 8);
#define GRID_BAR() xcd_barrier(bar)
#else
#define GRID_BAR() do {} while (0)
#endif
    const int lo = args.ph_lo, hi = args.ph_hi;
#define IN(k) (lo <= (k) && (k) < hi)
#define BOTH(k) (IN(k) && IN((k) + 1))

    if (IN(0)) { p0_prologue(F); if (BOTH(0)) GRID_BAR(); }
    if (IN(1)) {
        pg8::Gemm g{WSP(bf16, WS_XN), WSP(bf16, WS_WIN), M, NPROJ, D}; pg8::StaticOrder S; S.init(M, NPROJ, F.G, (int)blockIdx.x);
        pg8::EpiBf16<0> E{WSP(bf16, WS_PROJ), NPROJ};
        pg8::gemm_phase<pg8::EpiBf16<0>, pg8::StaticOrder, PG8_ALIGN, PG8_SP2>(F.lds + RING_OFF, g, S, E);
        if (BOTH(1)) GRID_BAR();
    }
    if (IN(2)) { p2_token_prep(F); if (BOTH(2)) GRID_BAR(); }
    if (IN(3)) { p3_chunk_prep(F); if (BOTH(3)) GRID_BAR(); }
    if (IN(4)) {
#ifndef P4_MASK
#define P4_MASK 15
#endif
        if (P4_MASK & 1) for (int u = F.vcu; u < 64; u += F.G) p4_scan(F, u);
        if (P4_MASK & 2) for (int u = F.vcu; u < 512; u += F.G) p4d_attn_sample(F, u);
        if (P4_MASK & 4) for (int u = F.G - 1 - F.vcu; u < 256; u += F.G) p4c_attn_prompt(F, u * 8 + F.wave);
        if (P4_MASK & 8) for (int u = F.G - 1 - F.vcu; u < 512; u += F.G) p4b_sample_delta(F, u);
        if (BOTH(4)) GRID_BAR();
    }
    if (IN(5)) { p5_gate(F); if (BOTH(5)) GRID_BAR(); }
    if (IN(6)) {
        pg8::Gemm g{WSP(bf16, WS_MIX), WSP(bf16, WS_WO), M, D, D}; pg8::StaticOrder S; S.init(M, D, F.G, (int)blockIdx.x);
        pg8::EpiResF32 E{F.xp, F.xs, MP, F.out, D};
        pg8::gemm_phase<pg8::EpiResF32, pg8::StaticOrder, PG8_ALIGN, PG8_SP2>(F.lds + RING_OFF, g, S, E);
        if (BOTH(6)) GRID_BAR();
    }
    if (IN(7)) { p7_norm2(F); if (BOTH(7)) GRID_BAR(); }
    if (IN(8)) {
        pg8::Gemm g{WSP(bf16, WS_XN), WSP(bf16, WS_WUP), M, FF, D}; pg8::StaticOrder S; S.init(M, FF, F.G, (int)blockIdx.x);
        pg8::EpiBf16<2> E{WSP(bf16, WS_HID), FF};
        pg8::gemm_phase<pg8::EpiBf16<2>, pg8::StaticOrder, PG8_ALIGN, PG8_SP2>(F.lds + RING_OFF, g, S, E);
        if (BOTH(8)) GRID_BAR();
    }
    if (IN(9)) {
        pg8::Gemm g{WSP(bf16, WS_HID), WSP(bf16, WS_WDN), M, D, FF}; pg8::StaticOrder S; S.init(M, D, F.G, (int)blockIdx.x);
        pg8::EpiResF32 E{F.out, F.out + (size_t)MP * D, MP, F.out, D};
        pg8::gemm_phase<pg8::EpiResF32, pg8::StaticOrder, PG8_ALIGN, PG8_SP2>(F.lds + RING_OFF, g, S, E);
    }
#undef IN
#undef BOTH
}

extern "C" void kernel_launch(void* const* d_in, const int* in_sizes, int n_in, void* d_out, int out_size, void* d_ws, size_t ws_size, hipStream_t stream) {
    static int grid = 0;
    if (grid == 0) {
        if (n_in != 18 || (size_t)out_size != O_END || ws_size < WS_END) { fprintf(stderr, "kernel_launch: unexpected shapes (n_in %d out %d ws %zu need %zu)\n", n_in, out_size, ws_size, (size_t)WS_END); grid = -1; return; }
        int dev = 0, cus = 0, per_cu = 0;
        if (hipGetDevice(&dev) != hipSuccess || hipDeviceGetAttribute(&cus, hipDeviceAttributeMultiprocessorCount, dev) != hipSuccess) { grid = -1; return; }
        if (hipFuncSetAttribute((const void*)hymba_fwd, hipFuncAttributeMaxDynamicSharedMemorySize, LDS_BYTES) != hipSuccess) { fprintf(stderr, "kernel_launch: hipFuncSetAttribute failed\n"); grid = -1; return; }
        if (hipOccupancyMaxActiveBlocksPerMultiprocessor(&per_cu, (const void*)hymba_fwd, NWAVES * 64, LDS_BYTES) != hipSuccess || per_cu < 1) fprintf(stderr, "kernel_launch: occupancy query reports %d\n", per_cu);
        (void)hipGetLastError();
        grid = cus;
    }
    if (grid < 0) return;
    (void)hipMemsetAsync((char*)d_ws + WS_CTL, 0, CTL_ZERO_BYTES, stream);
#ifdef DBG_ZERO_OUT
    (void)hipMemsetAsync(d_out, 0, (size_t)out_size * 4, stream);
#endif
    Args a{};
    for (int i = 0; i < 18; ++i) a.in[i] = (const float*)d_in[i];
    a.out = (float*)d_out; a.ws = (unsigned char*)d_ws;
#if MK_ONE_LAUNCH
    a.ph_lo = 0; a.ph_hi = N_PHASES;
    hipLaunchKernelGGL(hymba_fwd, dim3(grid), dim3(NWAVES * 64), LDS_BYTES, stream, a);
#else
    for (int p = 0; p < PH_LIMIT; ++p) { a.ph_lo = p; a.ph_hi = p + 1; hipLaunchKernelGGL(hymba_fwd, dim3(grid), dim3(NWAVES * 64), LDS_BYTES, stream, a); }
#endif
}
```

```cpp
#include <hip/hip_runtime.h>
#include <cstdio>
#include <cstdint>
namespace pg8 {
#define PG8_LAS __attribute__((address_space(3)))
typedef unsigned short bf16_t;
typedef short bf16x8 __attribute__((ext_vector_type(8)));
typedef float f32x4 __attribute__((ext_vector_type(4)));
typedef unsigned u32x4 __attribute__((ext_vector_type(4)));
constexpr int BM = 256, BK = 64, HALF = 128, HTB = HALF * BK * 2  , STAGE_BYTES = 8 * HTB, NXCD = 8, WGM = 8;

__host__ __device__ __forceinline__ int lds_byte(int r, int c) { const int st = (r >> 4) * 2 + (c >> 5), rr = r & 15, cc = c & 31, ob = rr * 64 + cc * 2; return st * 1024 + (ob ^ (((ob >> 9) & 1) << 5)); }
__host__ __device__ __forceinline__ void stage_rc(int b, int& R, int& C) { const int st = b / 1024, sb = b % 1024, swz = sb ^ (((sb >> 9) & 1) << 5); R = (st >> 1) * 16 + swz / 64; C = (st & 1) * 32 + (swz % 64) / 2; }
__host__ __device__ __forceinline__ int perm32(int rho) { const int n = rho >> 4, i = rho & 15; return 8 * (i >> 2) + 4 * n + (i & 3); }

struct Unit { int pm, pn, k0; };
struct Gemm { const bf16_t* A; const bf16_t* Bt; int M, N, K, Kloop; };

struct StaticOrder {
    static constexpr bool SPLIT = false;
    int nM, nN, nwg, G, c;
    __host__ __device__ void init(int M, int N, int G_, int c_) { nM = M / BM; nN = N / BM; nwg = nM * nN; G = G_; c = c_; }
    __host__ __device__ bool next(int i, Unit& u) const {
        const long L = (long)i * G + c; if (L >= nwg) return false;
        int wgid = (int)L; { const int q = nwg / NXCD, r = nwg % NXCD, xcd = wgid % NXCD, off = wgid / NXCD; wgid = (xcd < r ? xcd * (q + 1) : r * (q + 1) + (xcd - r) * q) + off; }
        const int nig = WGM * nN, gid = wgid / nig, fm = gid * WGM, gsz = (nM - fm) < WGM ? (nM - fm) : WGM;
        u.pm = fm + ((wgid % nig) % gsz); u.pn = (wgid % nig) / gsz; u.k0 = 0; return true;
    }
    __device__ __forceinline__ void a_ready(const Unit&) const {}
    __device__ __forceinline__ void done(const Unit&) const {}
};

typedef float f32x2 __attribute__((ext_vector_type(2)));
typedef __bf16 bf16x2 __attribute__((ext_vector_type(2)));
__device__ __forceinline__ unsigned cvt_pk_bf16(float lo, float hi) { f32x2 v = {lo, hi}; bf16x2 b = __builtin_convertvector(v, bf16x2); return __builtin_bit_cast(unsigned, b); }
template <int ACT> struct EpiBf16 {
    static constexpr bool PERM = true, AFTER_DRAIN = false;
    bf16_t* O; int ldc;
    __device__ __forceinline__ void operator()(const f32x4 (&acc)[2][2][4][2], const Unit& u, int wr, int wc, int fr, int fq) const {
        const int row0 = u.pm * BM + wr * 64 + fr; const int col0 = u.pn * BM + wc * 32 + 8 * fq;
#pragma unroll
        for (int ai = 0; ai < 2; ++ai)
#pragma unroll
            for (int m = 0; m < 4; ++m) { bf16_t* rowp = O + (size_t)(row0 + ai * HALF + m * 16) * ldc + col0;
#pragma unroll
                for (int bj = 0; bj < 2; ++bj) { f32x4 v0 = acc[ai][bj][m][0], v1 = acc[ai][bj][m][1];
                    if (ACT == 2) {
#pragma unroll
                        for (int e = 0; e < 4; ++e) { const float a = fmaxf(v0[e], 0.f), b = fmaxf(v1[e], 0.f); v0[e] = a * a; v1[e] = b * b; } }
                    u32x4 w; w.x = cvt_pk_bf16(v0[0], v0[1]); w.y = cvt_pk_bf16(v0[2], v0[3]); w.z = cvt_pk_bf16(v1[0], v1[1]); w.w = cvt_pk_bf16(v1[2], v1[3]);
                    *(u32x4*)(rowp + bj * HALF) = w; } }
    }
};
struct EpiResF32 {
    static constexpr bool PERM = false, AFTER_DRAIN = false;
    const float* base; const float* base2; int split; float* out; int ldc;
    __device__ __forceinline__ void operator()(const f32x4 (&acc)[2][2][4][2], const Unit& u, int wr, int wc, int fr, int fq) const {
        const int col0 = u.pn * BM + wc * 32 + 4 * fq;
        const float* bs = (u.pm * BM >= split) ? base2 - (size_t)split * ldc : base;
#pragma unroll
        for (int ai = 0; ai < 2; ++ai)
#pragma unroll
            for (int m = 0; m < 4; ++m) { const size_t off = (size_t)(u.pm * BM + ai * HALF + wr * 64 + m * 16 + fr) * ldc + col0;
#pragma unroll
                for (int bj = 0; bj < 2; ++bj)
#pragma unroll
                    for (int n = 0; n < 2; ++n) { const f32x4 b = *(const f32x4*)(bs + off + bj * HALF + n * 16); *(f32x4*)(out + off + bj * HALF + n * 16) = b + acc[ai][bj][m][n]; }
                if (m & 1) asm volatile("" ::: "memory"); }
    }
};
struct SplitOrder {
    static constexpr bool SPLIT = true;
    int pm0, nN, parts, ktiles, nitems, c;
    __host__ __device__ void init(int pm0_, int ntm, int nN_, int parts_, int ktiles_, int c_) { pm0 = pm0_; nN = nN_; parts = parts_; ktiles = ktiles_; nitems = ntm * nN_ * parts_; c = c_; }
    __host__ __device__ bool next(int i, Unit& u) const { if (i != 0 || c >= nitems) return false; const int tile = c / parts, kp = c - tile * parts; u.pm = pm0 + tile / nN; u.pn = tile % nN; u.k0 = kp * ktiles; return true; }
    __device__ __forceinline__ void a_ready(const Unit&) const {}
    __device__ __forceinline__ void done(const Unit&) const {}
};
struct EpiSplit {
    static constexpr bool PERM = false, AFTER_DRAIN = true;
    float* slab; unsigned* cnt; const float* base; float* out; int ldc, pm0, nN, parts, ktiles;
    __device__ __forceinline__ void fused(f32x4 (&acc)[2][2][4][2], const Unit& u, int wr, int wc, int fr, int fq, PG8_LAS unsigned char* lds, int wid, int lane) const {
        const int tile = (u.pm - pm0) * nN + u.pn, part = u.k0 / ktiles;
        typedef __attribute__((address_space(1))) unsigned long long gu64_t;
        float* sp = slab + ((size_t)(tile * parts + part) * 32 * 8 + wid) * 256 + lane * 4;
#pragma unroll
        for (int ai = 0; ai < 2; ++ai)
#pragma unroll
            for (int bj = 0; bj < 2; ++bj)
#pragma unroll
                for (int m = 0; m < 4; ++m)
#pragma unroll
                    for (int n = 0; n < 2; ++n) { const int i32 = ((ai * 2 + bj) * 4 + m) * 2 + n; const f32x4 v = acc[ai][bj][m][n]; gu64_t* q = (gu64_t*)(sp + (size_t)i32 * 2048);
                        __hip_atomic_store(q, ((unsigned long long)__float_as_uint(v[1]) << 32) | __float_as_uint(v[0]), __ATOMIC_RELAXED, __HIP_MEMORY_SCOPE_AGENT);
                        __hip_atomic_store(q + 1, ((unsigned long long)__float_as_uint(v[3]) << 32) | __float_as_uint(v[2]), __ATOMIC_RELAXED, __HIP_MEMORY_SCOPE_AGENT); }
        asm volatile("s_waitcnt vmcnt(0)" ::: "memory"); __builtin_amdgcn_s_barrier(); asm volatile("" ::: "memory");
        PG8_LAS unsigned* flag = (PG8_LAS unsigned*)lds;
        if (wid == 0 && lane == 0) flag[0] = __hip_atomic_fetch_add(cnt + 64 * tile, 1u, __ATOMIC_RELAXED, __HIP_MEMORY_SCOPE_AGENT);
        asm volatile("s_waitcnt vmcnt(0) lgkmcnt(0)" ::: "memory"); __builtin_amdgcn_s_barrier(); asm volatile("" ::: "memory");
        if ((int)flag[0] != parts - 1) return;
        __builtin_amdgcn_fence(__ATOMIC_ACQUIRE, "agent"); asm volatile("s_waitcnt vmcnt(0)" ::: "memory");
        const float* s0 = slab + ((size_t)(tile * parts) * 32 * 8 + wid) * 256 + lane * 4;
        const int col0 = u.pn * BM + wc * 32 + 4 * fq;
#pragma unroll
        for (int ai = 0; ai < 2; ++ai)
#pragma unroll
            for (int m = 0; m < 4; ++m) { const size_t off = (size_t)(u.pm * BM + ai * HALF + wr * 64 + m * 16 + fr) * ldc + col0;
#pragma unroll
                for (int bj = 0; bj < 2; ++bj)
#pragma unroll
                    for (int n = 0; n < 2; ++n) { const int i32 = ((ai * 2 + bj) * 4 + m) * 2 + n; f32x4 s = *(const f32x4*)(base + off + bj * HALF + n * 16);
                        for (int p = 0; p < parts; ++p) s += *(const __attribute__((address_space(1))) f32x4*)(s0 + ((size_t)p * 32 * 8) * 256 + (size_t)i32 * 2048);
                        *(f32x4*)(out + off + bj * HALF + n * 16) = s; }
                asm volatile("" ::: "memory"); }
    }
};
template <class Epi, class Sched, bool ALIGN_EPI = false, bool SP2 = false>
__device__ __forceinline__ void gemm_phase(PG8_LAS unsigned char* lds, const Gemm g, const Sched& S, const Epi& E) {
    const int tid = threadIdx.x, wid = __builtin_amdgcn_readfirstlane(tid >> 6), lane = tid & 63, wr = wid >> 2, wc = wid & 3, fr = lane & 15, fq = lane >> 4;
    const int K = g.K, nt = g.Kloop / BK;
    unsigned voffA[2], voffB[2];
#pragma unroll
    for (int i = 0; i < 2; ++i) { int R, C; stage_rc(tid * 16 + i * 8192, R, C); const int Rb = Epi::PERM ? ((R & ~31) + perm32(R & 31)) : R;
        voffA[i] = (unsigned)(R * K + C) * 2u; voffB[i] = (unsigned)(Rb * K + C) * 2u; }
    const size_t kstep = (size_t)(BK * 2);
    const size_t hstep = (size_t)HALF * K * 2;
    const size_t tstep = 2 * hstep;
    const unsigned ldsw = (unsigned)wid * 1024u;
    const int aoff = lds_byte(wr * 64 + fr, fq * 8), boff = lds_byte(wc * 32 + fr, fq * 8);
#define PG8_SA(b, h) (((b) * 2 + (h)) * HTB)
#define PG8_SB(b, h) ((4 + (b) * 2 + (h)) * HTB)
#define PG8_STAGE(bufoff, gbase, voff) do { _Pragma("unroll") for (int _i = 0; _i < 2; ++_i) \
        __builtin_amdgcn_global_load_lds((const unsigned*)((const char*)(gbase) + (voff)[_i]), (PG8_LAS unsigned*)(lds + (bufoff) + ldsw + _i * 8192), 16, 0, 0); } while (0)
#define PG8_LDA(dst, b, h) do { _Pragma("unroll") for (int m = 0; m < 4; ++m) _Pragma("unroll") for (int k = 0; k < 2; ++k) dst[m][k] = *(const PG8_LAS bf16x8*)(lds + PG8_SA(b, h) + aoff + m * 2048 + k * 1024); } while (0)
#define PG8_LDB(dst, b, h) do { _Pragma("unroll") for (int n = 0; n < 2; ++n) _Pragma("unroll") for (int k = 0; k < 2; ++k) dst[n][k] = *(const PG8_LAS bf16x8*)(lds + PG8_SB(b, h) + boff + n * 2048 + k * 1024); } while (0)
#define PG8_MMA(ai, bj, At, Bt) do { __builtin_amdgcn_s_setprio(1); _Pragma("unroll") for (int m = 0; m < 4; ++m) _Pragma("unroll") for (int n = 0; n < 2; ++n) _Pragma("unroll") for (int k = 0; k < 2; ++k) \
        acc[ai][bj][m][n] = __builtin_amdgcn_mfma_f32_16x16x32_bf16(Bt[n][k], At[m][k], acc[ai][bj][m][n], 0, 0, 0); __builtin_amdgcn_s_setprio(0); } while (0)
#define PG8_WAIT_V(n) asm volatile("s_waitcnt vmcnt(" #n ")" ::: "memory")
#define PG8_WAIT_L(n) asm volatile("s_waitcnt lgkmcnt(" #n ")" ::: "memory")
#define PG8_BAR __builtin_amdgcn_s_barrier()
#define PG8_SCHED __builtin_amdgcn_sched_barrier(0)
    Unit cur, nxt; int ui = 0;
    if (!S.next(0, cur)) return;
    f32x4 acc[2][2][4][2];
#pragma unroll
    for (int a = 0; a < 2; ++a)
#pragma unroll
        for (int b = 0; b < 2; ++b)
#pragma unroll
            for (int m = 0; m < 4; ++m)
#pragma unroll
                for (int n = 0; n < 2; ++n) acc[a][b][m][n] = (f32x4){0.f, 0.f, 0.f, 0.f};
    bf16x8 At[4][2], B0[2][2], B1[2][2];
    const char* cA = (const char*)g.A + (size_t)cur.pm * tstep + (Sched::SPLIT ? (size_t)cur.k0 * kstep : 0); const char* cB = (const char*)g.Bt + (size_t)cur.pn * tstep + (Sched::SPLIT ? (size_t)cur.k0 * kstep : 0);
    S.a_ready(cur);
    if constexpr (SP2) {
        PG8_STAGE(PG8_SB(0, 0), cB, voffB); PG8_STAGE(PG8_SB(0, 1), cB + hstep, voffB); PG8_STAGE(PG8_SA(0, 0), cA, voffA); PG8_STAGE(PG8_SA(0, 1), cA + hstep, voffA);
        if (wr == 1) PG8_BAR;
        PG8_WAIT_V(2); PG8_BAR;
        PG8_STAGE(PG8_SB(1, 0), cB + kstep, voffB); PG8_STAGE(PG8_SA(1, 0), cA + kstep, voffA); PG8_STAGE(PG8_SB(1, 1), cB + hstep + kstep, voffB);
        PG8_WAIT_V(6); PG8_BAR;
    } else {
        PG8_STAGE(PG8_SB(0, 0), cB, voffB); PG8_STAGE(PG8_SA(0, 0), cA, voffA); PG8_STAGE(PG8_SB(0, 1), cB + hstep, voffB); PG8_STAGE(PG8_SA(0, 1), cA + hstep, voffA);
        if (wr == 1) PG8_BAR;
        PG8_WAIT_V(4); PG8_BAR;
        PG8_STAGE(PG8_SB(1, 0), cB + kstep, voffB); PG8_STAGE(PG8_SA(1, 0), cA + kstep, voffA); PG8_STAGE(PG8_SB(1, 1), cB + hstep + kstep, voffB);
        PG8_WAIT_V(6); PG8_BAR;
    }
    for (;;) {
        const bool has_next = S.next(ui + 1, nxt);
        const char* nA = has_next ? (const char*)g.A + (size_t)nxt.pm * tstep + (Sched::SPLIT ? (size_t)nxt.k0 * kstep : 0) : cA; const char* nB = has_next ? (const char*)g.Bt + (size_t)nxt.pn * tstep + (Sched::SPLIT ? (size_t)nxt.k0 * kstep : 0) : cB;
        for (int t = 0; t < nt; t += 2) {
            const bool last = (t == nt - 2);
            const char* a1 = cA + (size_t)(t + 1) * kstep;
            const char* a2 = last ? nA : cA + (size_t)(t + 2) * kstep; const char* b2 = last ? nB : cB + (size_t)(t + 2) * kstep;
            const char* a3 = a2 + kstep; const char* b3 = b2 + kstep;
            if (last && has_next) S.a_ready(nxt);
            if constexpr (SP2) {
            PG8_LDB(B0, 0, 0); PG8_LDB(B1, 0, 1); PG8_SCHED; PG8_LDA(At, 0, 0); PG8_STAGE(PG8_SA(1, 1), a1 + hstep, voffA);
            PG8_WAIT_V(8); PG8_WAIT_L(0); PG8_BAR; PG8_MMA(0, 0, At, B0); PG8_MMA(0, 1, At, B1); PG8_BAR; PG8_SCHED;
            PG8_LDA(At, 0, 1); PG8_STAGE(PG8_SB(0, 0), b2, voffB); PG8_STAGE(PG8_SB(0, 1), b2 + hstep, voffB); PG8_STAGE(PG8_SA(0, 0), a2, voffA);
            PG8_WAIT_V(8); PG8_WAIT_L(0); PG8_BAR; PG8_MMA(1, 0, At, B0); PG8_MMA(1, 1, At, B1); PG8_BAR; PG8_SCHED;
            PG8_LDB(B0, 1, 0); PG8_LDB(B1, 1, 1); PG8_SCHED; PG8_LDA(At, 1, 0); PG8_STAGE(PG8_SA(0, 1), a2 + hstep, voffA);
            PG8_WAIT_V(8); PG8_WAIT_L(0); PG8_BAR; PG8_MMA(0, 0, At, B0); PG8_MMA(0, 1, At, B1); PG8_BAR; PG8_SCHED;
            PG8_LDA(At, 1, 1); PG8_STAGE(PG8_SB(1, 0), b3, voffB); PG8_STAGE(PG8_SB(1, 1), b3 + hstep, voffB); PG8_STAGE(PG8_SA(1, 0), a3, voffA);
            PG8_WAIT_V(8); PG8_WAIT_L(0); PG8_BAR; PG8_MMA(1, 0, At, B0); PG8_MMA(1, 1, At, B1); PG8_BAR; PG8_SCHED;
            } else {
            PG8_LDB(B0, 0, 0); PG8_SCHED; PG8_LDA(At, 0, 0); PG8_STAGE(PG8_SA(1, 1), a1 + hstep, voffA);
            PG8_WAIT_L(8); PG8_BAR; PG8_WAIT_L(0); PG8_MMA(0, 0, At, B0); PG8_BAR; PG8_SCHED;
            PG8_LDB(B1, 0, 1); PG8_STAGE(PG8_SB(0, 0), b2, voffB);
            PG8_BAR; PG8_WAIT_L(0); PG8_MMA(0, 1, At, B1); PG8_BAR;
            PG8_LDA(At, 0, 1); PG8_STAGE(PG8_SA(0, 0), a2, voffA);
            PG8_BAR; PG8_WAIT_L(0); PG8_MMA(1, 0, At, B0); PG8_BAR; PG8_SCHED;
            PG8_STAGE(PG8_SB(0, 1), b2 + hstep, voffB);
            PG8_WAIT_V(6); PG8_BAR; PG8_MMA(1, 1, At, B1); PG8_BAR;
            PG8_LDB(B0, 1, 0); PG8_SCHED; PG8_LDA(At, 1, 0); PG8_STAGE(PG8_SA(0, 1), a2 + hstep, voffA);
            PG8_WAIT_L(8); PG8_BAR; PG8_WAIT_L(0); PG8_MMA(0, 0, At, B0); PG8_BAR; PG8_SCHED;
            PG8_LDB(B1, 1, 1); PG8_STAGE(PG8_SB(1, 0), b3, voffB);
            PG8_BAR; PG8_WAIT_L(0); PG8_MMA(0, 1, At, B1); PG8_BAR;
            PG8_LDA(At, 1, 1); PG8_STAGE(PG8_SA(1, 0), a3, voffA);
            PG8_BAR; PG8_WAIT_L(0); PG8_MMA(1, 0, At, B0); PG8_BAR; PG8_SCHED;
            PG8_STAGE(PG8_SB(1, 1), b3 + hstep, voffB);
            PG8_WAIT_V(6); PG8_BAR; PG8_MMA(1, 1, At, B1); PG8_BAR;
            }
        }
        if constexpr (ALIGN_EPI) { if (wr == 0) PG8_BAR; }
        if constexpr (!Epi::AFTER_DRAIN) { E(acc, cur, wr, wc, fr, fq); S.done(cur); }
        if (!has_next) break;
#pragma unroll
        for (int a = 0; a < 2; ++a)
#pragma unroll
            for (int b = 0; b < 2; ++b)
#pragma unroll
                for (int m = 0; m < 4; ++m)
#pragma unroll
                    for (int n = 0; n < 2; ++n) acc[a][b][m][n] = (f32x4){0.f, 0.f, 0.f, 0.f};
        cur = nxt; cA = nA; cB = nB; ++ui;
        if constexpr (ALIGN_EPI) { if (wr == 1) PG8_BAR; }
    }
    PG8_WAIT_V(0);
    if constexpr (!ALIGN_EPI) { if (wr == 0) PG8_BAR; }
    PG8_BAR;
    if constexpr (Epi::AFTER_DRAIN) { E.fused(acc, cur, wr, wc, fr, fq, lds, wid, lane); S.done(cur); }
#undef PG8_SA
#undef PG8_SB
#undef PG8_STAGE
#undef PG8_LDA
#undef PG8_LDB
#undef PG8_MMA
#undef PG8_WAIT_V
#undef PG8_WAIT_L
#undef PG8_BAR
#undef PG8_SCHED
}
}

#ifndef PG8_SP2
#define PG8_SP2 true
#endif
#ifndef PG8_ALIGN
#define PG8_ALIGN true
#endif
#ifndef MK_ONE_LAUNCH
#define MK_ONE_LAUNCH 1
#endif

constexpr int NWAVES = 8;
constexpr int D = 1024, NB = 4, SEQ = 4096, MP = NB * SEQ, NSB = 128, ST = 8, MS = NSB * ST, M = MP + MS;
constexpr int HA = 4, DA = 128, WA = 512, HB = 8, DB = 64, WB = 512, CONVC = 1536, FF = 4096, WBUF = 2048;
constexpr int PCOLS = 3592, NPROJ = 3584;
constexpr int PC_Z = 1536, PC_QB = 2048, PC_KB = 2560, PC_VB = 3072;
constexpr int NCH = SEQ / 64, NBH = NB * HA;
constexpr float EPS = 1e-6f;
constexpr float QB_SCALE = 0.125f * 1.4426950408889634f;

constexpr size_t O_YP = 0, O_YS = (size_t)MP * D, O_KP = O_YS + (size_t)MS * D, O_VP = O_KP + (size_t)NB * WBUF * WB, O_DP = O_VP + (size_t)NB * WBUF * WB,
                 O_CP = O_DP + (size_t)NBH * DA * DA, O_KS = O_CP + (size_t)NB * 3 * CONVC, O_VS = O_KS + (size_t)MS * WB, O_DS = O_VS + (size_t)MS * WB,
                 O_CS = O_DS + (size_t)NSB * HA * DA * DA, O_END = O_CS + (size_t)NSB * 3 * CONVC;
static_assert(O_END == 36521984, "output size");

constexpr size_t al256(size_t x) { return (x + 255) & ~(size_t)255; }
constexpr size_t WS_CTL = 0, CTL_ZERO_BYTES = 1u << 20;
constexpr size_t WS_WIN = CTL_ZERO_BYTES;
constexpr size_t WS_WO = WS_WIN + (size_t)NPROJ * D * 2;
constexpr size_t WS_WUP = WS_WO + (size_t)D * D * 2;
constexpr size_t WS_WDN = WS_WUP + (size_t)FF * D * 2;
constexpr size_t WS_XN = WS_WDN + (size_t)FF * D * 2;
constexpr size_t WS_PROJ = WS_XN + (size_t)M * D * 2;
constexpr size_t WS_BETA = WS_PROJ + (size_t)M * NPROJ * 2;
constexpr size_t WS_GG = WS_BETA + (size_t)M * 4 * 4;
constexpr size_t WS_GC = WS_GG + (size_t)M * 4 * 4;
constexpr size_t WS_CS = WS_GC + (size_t)NBH * SEQ * 4;
constexpr size_t WS_QA = WS_CS + (size_t)NBH * NCH * 64 * 4;
constexpr size_t WS_KA = WS_QA + (size_t)NBH * SEQ * DA * 2;
constexpr size_t WS_KAT = WS_KA + (size_t)NBH * SEQ * DA * 2;
constexpr size_t WS_VAT = WS_KAT + (size_t)NBH * SEQ * DA * 2;
constexpr size_t WS_WF = WS_VAT + (size_t)NBH * SEQ * DA * 2;
constexpr size_t WS_UF = WS_WF + (size_t)NBH * NCH * 16 * 1024;
constexpr size_t WS_QKF = WS_UF + (size_t)NBH * NCH * 32 * 1024;
constexpr size_t WS_OA = WS_QKF + (size_t)NBH * NCH * 8 * 1024;
constexpr size_t WS_Q16 = WS_OA + (size_t)M * WA * 4;
constexpr size_t WS_K16 = WS_Q16 + (size_t)MP * WB * 2;
constexpr size_t WS_VT16 = WS_K16 + (size_t)MP * WB * 2;
constexpr size_t WS_QSB = WS_VT16 + (size_t)MP * WB * 2;
constexpr size_t WS_QKVS = WS_QSB + (size_t)MS * WB * 4;
constexpr size_t WS_MIX = WS_QKVS + (size_t)MS * CONVC * 4;
constexpr size_t WS_HID = WS_MIX + (size_t)M * D * 2;
constexpr size_t WS_SLAB = WS_HID + (size_t)M * FF * 2;
constexpr size_t WS_END = WS_SLAB + (size_t)16 * 8 * 262144;
static_assert(WS_END % 256 == 0 && WS_WIN % 256 == 0, "ws alignment");
constexpr int CW_BAR = 4096, CW_Q = 8192, CW_T = 8256 + 1024, CW_SPLIT = 16384;

constexpr int RING_OFF = 0, RING_BYTES = 131072;
constexpr int LDSCTL_OFF = RING_BYTES, MISC_OFF = LDSCTL_OFF + 320;
constexpr int LDS_BYTES = 147456;

#define GAS __attribute__((address_space(1)))
#define LAS __attribute__((address_space(3)))
typedef unsigned short bf16;
typedef unsigned v4u __attribute__((ext_vector_type(4)));
typedef float f32x4 __attribute__((ext_vector_type(4)));
typedef short bf16x8 __attribute__((ext_vector_type(8)));
typedef GAS unsigned gu32;
typedef GAS unsigned long long gu64;
#define RLX_AGENT __ATOMIC_RELAXED, __HIP_MEMORY_SCOPE_AGENT
#define LDS_WAIT() asm volatile("s_waitcnt lgkmcnt(0)" ::: "memory")
#define VM_WAIT() asm volatile("s_waitcnt vmcnt(0)" ::: "memory")
__device__ __forceinline__ unsigned long long rt() { return __builtin_amdgcn_s_memrealtime(); }
__device__ __forceinline__ unsigned f2bf(float f) { unsigned u = __builtin_bit_cast(unsigned, f); return (u + 0x7fffu + ((u >> 16) & 1u)) >> 16; }
__device__ __forceinline__ unsigned pk2(float lo, float hi) { return f2bf(lo) | (f2bf(hi) << 16); }

#define XB_TMO      128
#define XB_XCNT(j)  (256  + 64 * (j))
#define XB_XSUB(j)  (1280 + 64 * (j))
#define XB_XGEN(j)  (2304 + 64 * (j))
#define XB_TOP      3328
#define XB_TOPGEN   3392
#define XCD_BAR_WORDS 3456
#define XB_SPIN_CAP (1u << 18)

__device__ __forceinline__ unsigned xb_ld(unsigned* p)              { return __hip_atomic_load(p, __ATOMIC_RELAXED, __HIP_MEMORY_SCOPE_AGENT); }
__device__ __forceinline__ unsigned xb_add(unsigned* p, unsigned v) { return __hip_atomic_fetch_add(p, v, __ATOMIC_RELAXED, __HIP_MEMORY_SCOPE_AGENT); }
__device__ __forceinline__ unsigned xb_xcc_id() { return (unsigned)__builtin_amdgcn_s_getreg((3 << 11) | 20) & 0xFu; }
#define XB_SPIN(cond, bar) do { unsigned _sp = 0; while (cond) { __builtin_amdgcn_s_sleep(1); \
    if ((++_sp & 255u) == 0u) { if (xb_ld(&(bar)[XB_TMO])) break; if (_sp > XB_SPIN_CAP) { atomicAdd(&(bar)[XB_TMO], 1u); break; } } } } while (0)

struct XcdBarrier {
    unsigned* bar; unsigned x;
    volatile LAS unsigned* st;
};

__device__ __forceinline__ XcdBarrier xcd_barrier_post(unsigned* bar, volatile LAS unsigned* st) {
    XcdBarrier b; b.bar = bar; b.x = xb_xcc_id(); b.st = st;
    if (threadIdx.x == 0) (void)xb_add(&bar[XB_XCNT(b.x)], 1u);
    return b;
}
__device__ __forceinline__ void xcd_barrier_complete(unsigned* bar, unsigned x, unsigned& nloc, unsigned& nx) {
    const unsigned G = gridDim.x * gridDim.y * gridDim.z;
    unsigned sum, cnt, mine, sp = 0u;
    for (;;) {
        sum = 0u; cnt = 0u; mine = 0u;
#pragma unroll
        for (unsigned j = 0; j < 16; ++j) { const unsigned c = xb_ld(&bar[XB_XCNT(j)]); sum += c; cnt += (c > 0u) ? 1u : 0u; mine = (j == x) ? c : mine; }
        if (sum == G) break;
        __builtin_amdgcn_s_sleep(1);
        if ((++sp & 255u) == 0u) { if (xb_ld(&bar[XB_TMO])) break; if (sp > XB_SPIN_CAP) { atomicAdd(&bar[XB_TMO], 1u); break; } }
    }
    nloc = mine > 0u ? mine : 1u; nx = cnt > 0u ? cnt : 1u;
}

__device__ __forceinline__ void xcd_barrier(const XcdBarrier& b) {
    asm volatile("s_waitcnt vmcnt(0)" ::: "memory");
    __syncthreads();
    if (threadIdx.x == 0) {
        unsigned* bar = b.bar;
        __builtin_amdgcn_s_waitcnt(0);
        unsigned nloc = b.st[0], nx = b.st[1];
        if (nloc == 0u) { xcd_barrier_complete(bar, b.x, nloc, nx); b.st[0] = nloc; b.st[1] = nx; }
        const unsigned old = xb_add(&bar[XB_XSUB(b.x)], 1u);
        const unsigned gen = old / nloc;
        if (old + 1u == (gen + 1u) * nloc) {
            __builtin_amdgcn_fence(__ATOMIC_RELEASE, "agent");
            asm volatile("s_waitcnt vmcnt(0)" ::: "memory");
            const unsigned og = xb_add(&bar[XB_TOP], 1u);
            const unsigned tg = og / nx;
            if (og + 1u == (tg + 1u) * nx) xb_add(&bar[XB_TOPGEN], 1u);
            else XB_SPIN(xb_ld(&bar[XB_TOPGEN]) == tg, bar);
            __builtin_amdgcn_fence(__ATOMIC_ACQUIRE, "agent");
            xb_add(&bar[XB_XGEN(b.x)], 1u);
            asm volatile("s_waitcnt vmcnt(0)" ::: "memory");
        } else {
            XB_SPIN(xb_ld(&bar[XB_XGEN(b.x)]) == gen, bar);
            __builtin_amdgcn_fence(__ATOMIC_ACQUIRE, "agent");
            asm volatile("s_waitcnt vmcnt(0)" ::: "memory");
        }
    }
    __syncthreads();
}


typedef float f32x2v __attribute__((ext_vector_type(2)));
typedef unsigned u32x2v __attribute__((ext_vector_type(2)));
typedef __bf16 bf16x2_t __attribute__((ext_vector_type(2)));
__device__ __forceinline__ unsigned cvtpk(float lo, float hi) { f32x2v v = {lo, hi}; bf16x2_t b = __builtin_convertvector(v, bf16x2_t); return __builtin_bit_cast(unsigned, b); }
__device__ __forceinline__ float bflo(unsigned u) { return __uint_as_float(u << 16); }
__device__ __forceinline__ float bfhi(unsigned u) { return __uint_as_float(u & 0xffff0000u); }
__device__ __forceinline__ void unpack8(const v4u w, float (&f)[8]) { f[0] = bflo(w.x); f[1] = bfhi(w.x); f[2] = bflo(w.y); f[3] = bfhi(w.y); f[4] = bflo(w.z); f[5] = bfhi(w.z); f[6] = bflo(w.w); f[7] = bfhi(w.w); }
__device__ __forceinline__ v4u pack8(const float (&f)[8]) { v4u w; w.x = cvtpk(f[0], f[1]); w.y = cvtpk(f[2], f[3]); w.z = cvtpk(f[4], f[5]); w.w = cvtpk(f[6], f[7]); return w; }
__device__ __forceinline__ float silu_f(float x) { return x * __builtin_amdgcn_rcpf(1.f + __expf(-x)); }
__device__ __forceinline__ bf16x8 as_bf16x8(v4u w) { return __builtin_bit_cast(bf16x8, w); }
__device__ __forceinline__ f32x4 mfma16(bf16x8 a, bf16x8 b, f32x4 c) { return __builtin_amdgcn_mfma_f32_16x16x32_bf16(a, b, c, 0, 0, 0); }
__device__ __forceinline__ int perm_tok(int x) { return 8 * ((x >> 2) & 3) + ((x >> 4) << 2) + (x & 3); }
__device__ __forceinline__ float wave_sum(float v) {
#pragma unroll
    for (int o = 1; o < 64; o <<= 1) v += __shfl_xor(v, o);
    return v;
}

struct Frame {
    LAS unsigned char* lds;
    volatile LAS unsigned* MISC;
    gu32* ctl;
    int tid, lane, wave;
    int vcu, G;
    const float *xp, *xs, *cache_k, *cache_v, *state_delta, *state_conv, *norm1_g, *w_in, *conv_w, *a_log, *dt_bias, *dng, *qng, *kng, *w_o, *norm2_g, *w_up, *w_down;
    float* out;
    unsigned char* ws;
};
#define WSP(T, off) ((T*)(F.ws + (off)))

__device__ __forceinline__ void p0_transpose_item(const float* W, int ldw, int col0, int K, bf16* WT, int row_off, LAS float* scr, int item, int nblk, int lane) {
    const int kb = item / nblk, nb = item % nblk, k0 = 64 * kb, n0 = 32 * nb;
    float wv[32];
#pragma unroll
    for (int i = 0; i < 32; ++i) { const int kk = 2 * i + (lane >> 5); wv[i] = *(const GAS float*)(W + (size_t)(k0 + kk) * ldw + col0 + n0 + (lane & 31)); }
#pragma unroll
    for (int i = 0; i < 32; ++i) { const int kk = 2 * i + (lane >> 5); scr[kk * 33 + (lane & 31)] = wv[i]; }
    LDS_WAIT(); asm volatile("" ::: "memory");
    const int c = lane & 7;
#pragma unroll
    for (int j = 0; j < 4; ++j) { const int n = (lane >> 3) + 8 * j; const LAS float* s = scr + (8 * c) * 33 + n;
        v4u o; o.x = cvtpk(s[0 * 33], s[1 * 33]); o.y = cvtpk(s[2 * 33], s[3 * 33]); o.z = cvtpk(s[4 * 33], s[5 * 33]); o.w = cvtpk(s[6 * 33], s[7 * 33]);
        *(GAS v4u*)(WT + (size_t)(row_off + n0 + n) * K + k0 + 8 * c) = o; }
    LDS_WAIT(); asm volatile("" ::: "memory");
}
__device__ __forceinline__ void p0_prologue(Frame& F) {
    const int gw = F.vcu * NWAVES + F.wave, NGW = F.G * NWAVES;
    {
        LAS float* scr = (LAS float*)(F.lds + RING_OFF + F.wave * 16384);
        constexpr int I_A = 16 * 64, I_B = 16 * 48, I_O = 16 * 32, I_U = 16 * 128, I_D = 64 * 32;
        constexpr int NITEMS = I_A + I_B + I_O + I_U + I_D;
        for (int it = gw; it < NITEMS; it += NGW) {
            int r = it;
            if (r < I_A) { p0_transpose_item(F.w_in, PCOLS, 0, D, WSP(bf16, WS_WIN), 0, scr, r, 64, F.lane); continue; } r -= I_A;
            if (r < I_B) { p0_transpose_item(F.w_in, PCOLS, 2056, D, WSP(bf16, WS_WIN), 2048, scr, r, 48, F.lane); continue; } r -= I_B;
            if (r < I_O) { p0_transpose_item(F.w_o, D, 0, D, WSP(bf16, WS_WO), 0, scr, r, 32, F.lane); continue; } r -= I_O;
            if (r < I_U) { p0_transpose_item(F.w_up, FF, 0, D, WSP(bf16, WS_WUP), 0, scr, r, 128, F.lane); continue; } r -= I_U;
            p0_transpose_item(F.w_down, D, 0, FF, WSP(bf16, WS_WDN), 0, scr, r, 32, F.lane);
        }
    }
    __syncthreads();
    {
        LAS float* wba = (LAS float*)(F.lds + RING_OFF);
        for (int i = F.tid; i < 1024 * 2; i += NWAVES * 64) { const int k = i >> 1, hh = i & 1; const f32x4 w = *(const f32x4*)(F.w_in + (size_t)k * PCOLS + 2048 + hh * 4);
            wba[(hh * 4 + 0) * 1024 + k] = w.x; wba[(hh * 4 + 1) * 1024 + k] = w.y; wba[(hh * 4 + 2) * 1024 + k] = w.z; wba[(hh * 4 + 3) * 1024 + k] = w.w; }
        __syncthreads();
        f32x4 g1[4];
#pragma unroll
        for (int j = 0; j < 4; ++j) g1[j] = *((const f32x4*)F.norm1_g + F.lane + 64 * j);
        f32x4 nv[4];
        { const int m = gw; const float* xrow = (m < MP) ? F.xp + (size_t)m * D : F.xs + (size_t)(m - MP) * D; const GAS f32x4* xr = (const GAS f32x4*)xrow + F.lane;
#pragma unroll
          for (int j = 0; j < 4; ++j) nv[j] = xr[64 * j]; }
        const int hsel = (F.lane >> 3) & 3;
        const float dtb = F.dt_bias[hsel], nexpa = -expf(F.a_log[hsel]);
        for (int m = gw; m < M; m += NGW) {
            f32x4 v[4]; float s = 0.f;
#pragma unroll
            for (int j = 0; j < 4; ++j) { v[j] = nv[j]; s += (v[j].x * v[j].x + v[j].y * v[j].y) + (v[j].z * v[j].z + v[j].w * v[j].w); }
            { const int mn = (m + NGW < M) ? m + NGW : m; const float* xrow = (mn < MP) ? F.xp + (size_t)mn * D : F.xs + (size_t)(mn - MP) * D; const GAS f32x4* xr = (const GAS f32x4*)xrow + F.lane;
#pragma unroll
              for (int j = 0; j < 4; ++j) nv[j] = xr[64 * j]; }
            const float rstd = 1.f / sqrtf(wave_sum(s) * (1.f / D) + EPS);
            float dots[8];
#pragma unroll
            for (int e = 0; e < 8; ++e) dots[e] = 0.f;
            GAS unsigned long long* o8 = (GAS unsigned long long*)(WSP(bf16, WS_XN) + (size_t)m * D) + F.lane;
#pragma unroll
            for (int j = 0; j < 4; ++j) { v[j] = v[j] * rstd * g1[j];
                o8[64 * j] = (unsigned long long)cvtpk(v[j].x, v[j].y) | ((unsigned long long)cvtpk(v[j].z, v[j].w) << 32);
#pragma unroll
                for (int e = 0; e < 8; ++e) { const f32x4 w = *(const LAS f32x4*)(wba + e * 1024 + 4 * F.lane + 256 * j); dots[e] += (v[j].x * w.x + v[j].y * w.y) + (v[j].z * w.z + v[j].w * w.w); } }
            float d4[4], d2[2], d1;
            { const bool hi = (F.lane & 32) != 0;
#pragma unroll
              for (int e = 0; e < 4; ++e) { const float keep = hi ? dots[e + 4] : dots[e], give = hi ? dots[e] : dots[e + 4]; d4[e] = keep + __shfl_xor(give, 32); } }
            { const bool hi = (F.lane & 16) != 0;
#pragma unroll
              for (int e = 0; e < 2; ++e) { const float keep = hi ? d4[e + 2] : d4[e], give = hi ? d4[e] : d4[e + 2]; d2[e] = keep + __shfl_xor(give, 16); } }
            { const bool hi = (F.lane & 8) != 0; const float keep = hi ? d2[1] : d2[0], give = hi ? d2[0] : d2[1]; d1 = keep + __shfl_xor(give, 8); }
            d1 += __shfl_xor(d1, 1); d1 += __shfl_xor(d1, 2); d1 += __shfl_xor(d1, 4);
            if ((F.lane & 7) == 0) {
                if (F.lane < 32) WSP(float, WS_BETA)[(size_t)m * 4 + hsel] = 1.f / (1.f + expf(-d1));
                else { const float xx = d1 + dtb; const float sp = (xx > 20.f) ? xx : log1pf(expf(xx)); WSP(float, WS_GG)[(size_t)m * 4 + hsel] = nexpa * sp; }
            }
        }
    }
}

template <bool SMP> __device__ __forceinline__ void p2_mixb_token(Frame& F, const bf16* PROJ, size_t row, int b, int t, int s, int tt, const float (&qg)[8], const float (&kg)[8], int lane) {
    const int hb = lane >> 3, d8 = (lane & 7) * 8, col8b = lane * 8;
    const size_t prow = row * NPROJ;
    float q[8], k[8], v[8];
    { const v4u w = *(const GAS v4u*)(PROJ + prow + PC_QB + col8b); unpack8(w, q); }
    { const v4u w = *(const GAS v4u*)(PROJ + prow + PC_KB + col8b); unpack8(w, k); }
    { const v4u w = *(const GAS v4u*)(PROJ + prow + PC_VB + col8b); unpack8(w, v); }
    float sq = 0.f, sk = 0.f;
#pragma unroll
    for (int e = 0; e < 8; ++e) { sq += q[e] * q[e]; sk += k[e] * k[e]; }
    sq += __shfl_xor(sq, 1); sq += __shfl_xor(sq, 2); sq += __shfl_xor(sq, 4);
    sk += __shfl_xor(sk, 1); sk += __shfl_xor(sk, 2); sk += __shfl_xor(sk, 4);
    const float rq = (1.f / sqrtf(sq * (1.f / DB) + EPS)) * QB_SCALE, rk = 1.f / sqrtf(sk * (1.f / DB) + EPS);
#pragma unroll
    for (int e = 0; e < 8; ++e) { q[e] *= rq * qg[e]; k[e] *= rk * kg[e]; }
    if (SMP) {
        const size_t o = ((size_t)(s * 8 + tt) * HB + hb) * DB + d8;
        float* qo = WSP(float, WS_QSB) + o; *(GAS f32x4*)qo = (f32x4){q[0], q[1], q[2], q[3]}; *(GAS f32x4*)(qo + 4) = (f32x4){q[4], q[5], q[6], q[7]};
        float* ko = F.out + O_KS + o; *(GAS f32x4*)ko = (f32x4){k[0], k[1], k[2], k[3]}; *(GAS f32x4*)(ko + 4) = (f32x4){k[4], k[5], k[6], k[7]};
        float* vo = F.out + O_VS + o; *(GAS f32x4*)vo = (f32x4){v[0], v[1], v[2], v[3]}; *(GAS f32x4*)(vo + 4) = (f32x4){v[4], v[5], v[6], v[7]};
    } else {
        const int c16 = t & 15, i16 = t >> 4;
        const size_t qi = ((((size_t)b * HB + hb) * 16 + c16) * 256 + i16) * DB + d8;
        *(GAS v4u*)(WSP(bf16, WS_Q16) + qi) = pack8(q);
        *(GAS v4u*)(WSP(bf16, WS_K16) + qi) = pack8(k);
        *(GAS v4u*)(WSP(bf16, WS_VT16) + qi) = pack8(v);
        if (t >= SEQ - WBUF) {
            const size_t o = (((size_t)b * WBUF + (t - (SEQ - WBUF))) * HB + hb) * DB + d8;
            float* ko = F.out + O_KP + o; *(GAS f32x4*)ko = (f32x4){k[0], k[1], k[2], k[3]}; *(GAS f32x4*)(ko + 4) = (f32x4){k[4], k[5], k[6], k[7]};
            float* vo = F.out + O_VP + o; *(GAS f32x4*)vo = (f32x4){v[0], v[1], v[2], v[3]}; *(GAS f32x4*)(vo + 4) = (f32x4){v[4], v[5], v[6], v[7]};
        }
    }
}
__device__ __forceinline__ void p2_load_gains(Frame& F, float (&qg)[8], float (&kg)[8], int lane) {
    const int d8 = (lane & 7) * 8;
    const f32x4 a = *(const GAS f32x4*)(F.qng + d8), c = *(const GAS f32x4*)(F.qng + d8 + 4), e2 = *(const GAS f32x4*)(F.kng + d8), f2 = *(const GAS f32x4*)(F.kng + d8 + 4);
    qg[0] = a.x; qg[1] = a.y; qg[2] = a.z; qg[3] = a.w; qg[4] = c.x; qg[5] = c.y; qg[6] = c.z; qg[7] = c.w; kg[0] = e2.x; kg[1] = e2.y; kg[2] = e2.z; kg[3] = e2.w; kg[4] = f2.x; kg[5] = f2.y; kg[6] = f2.z; kg[7] = f2.w;
}
__device__ __forceinline__ void p2_token_prep(Frame& F, int mode = 3) {
    const int lane = F.lane;
    const bf16* PROJ = WSP(bf16, WS_PROJ);
    for (int wj = F.vcu; wj < MP / 64; wj += F.G) {
        const int seg = wj * NWAVES + F.wave;
        const int b = seg >> 9, t0 = (seg & 511) * 8;
        const int row0 = b * SEQ + t0;
        const int hA = lane >> 4, dim8 = (lane & 15) * 8, bh = b * HA + hA;
#pragma unroll 1
        for (int j = 0; j < ((mode & 1) ? 3 : 0); ++j) {
            const int col8 = (lane + 64 * j) * 8;
            float cw[4][8];
#pragma unroll
            for (int i = 0; i < 4; ++i) { const f32x4 a = *(const GAS f32x4*)(F.conv_w + i * CONVC + col8), c = *(const GAS f32x4*)(F.conv_w + i * CONVC + col8 + 4);
                cw[i][0] = a.x; cw[i][1] = a.y; cw[i][2] = a.z; cw[i][3] = a.w; cw[i][4] = c.x; cw[i][5] = c.y; cw[i][6] = c.z; cw[i][7] = c.w; }
            float win[3][8];
#pragma unroll
            for (int i = 0; i < 3; ++i) {
                if (t0 == 0) {
#pragma unroll
                    for (int e = 0; e < 8; ++e) win[i][e] = 0.f; }
                else { const v4u w = *(const GAS v4u*)(PROJ + (size_t)(row0 - 3 + i) * NPROJ + col8); unpack8(w, win[i]); }
            }
            v4u xr[8];
#pragma unroll
            for (int tt = 0; tt < 8; ++tt) xr[tt] = *(const GAS v4u*)(PROJ + (size_t)(row0 + tt) * NPROJ + col8);
            unsigned tp[8][4];
            float prev[8];
#pragma unroll
            for (int tt = 0; tt < 8; ++tt) {
                float xn[8], y[8];
                unpack8(xr[tt], xn);
                float ss = 0.f;
#pragma unroll
                for (int e = 0; e < 8; ++e) { const float a = cw[0][e] * win[0][e] + cw[1][e] * win[1][e] + cw[2][e] * win[2][e] + cw[3][e] * xn[e]; y[e] = silu_f(a); ss += y[e] * y[e];
                    win[0][e] = win[1][e]; win[1][e] = win[2][e]; win[2][e] = xn[e]; }
                if (j < 2) {
                    ss += __shfl_xor(ss, 1); ss += __shfl_xor(ss, 2); ss += __shfl_xor(ss, 4); ss += __shfl_xor(ss, 8);
                    const float r = (1.f / sqrtf(ss + EPS)) * (j == 0 ? 0.08838834764831845f : 1.f);
#pragma unroll
                    for (int e = 0; e < 8; ++e) y[e] *= r;
                }
                if (tt >= 5 && t0 == SEQ - 8) {
                    float* o = F.out + O_CP + ((size_t)b * 3 + (tt - 5)) * CONVC + col8;
                    *(GAS f32x4*)o = (f32x4){xn[0], xn[1], xn[2], xn[3]}; *(GAS f32x4*)(o + 4) = (f32x4){xn[4], xn[5], xn[6], xn[7]};
                }
                if (j < 2) {
                    const int t = t0 + tt, ksq = (lane & 15) >> 2, fqp = lane & 3; const v4u w = pack8(y);
                    bf16* fb = WSP(bf16, j == 0 ? WS_QA : WS_KA) + ((((size_t)bh * (SEQ / 16) + (t >> 4)) * 4 + ksq) * 64) * 8 + (t & 15) * 8 + (fqp >> 1) * 4;
                    *(GAS u32x2v*)(fb + (((2 * fqp) & 3) << 4) * 8) = (u32x2v){w.x, w.y}; *(GAS u32x2v*)(fb + (((2 * fqp + 1) & 3) << 4) * 8) = (u32x2v){w.z, w.w};
                }
                if (j >= 1) {
                    if (tt & 1) {
#pragma unroll
                        for (int e = 0; e < 8; ++e) tp[e][tt >> 1] = cvtpk(prev[e], y[e]);
                    } else {
#pragma unroll
                        for (int e = 0; e < 8; ++e) prev[e] = y[e];
                    }
                }
            }
            if (j >= 1) {
                bf16* T = WSP(bf16, j == 1 ? WS_KAT : WS_VAT);
                const int nn = t0 >> 6, ca = t0 & 63, cb2 = ca + 4;
#pragma unroll
                for (int e = 0; e < 8; ++e) { const int dim = dim8 + e; bf16* base = T + ((((size_t)bh * NCH + nn) * 8 + (dim >> 4)) * 2) * 512 + (dim & 15) * 8;
                    *(GAS u32x2v*)(base + (ca >> 5) * 512 + (((ca >> 2) & 3) << 4) * 8 + ((ca >> 4) & 1) * 4) = (u32x2v){tp[e][0], tp[e][1]};
                    *(GAS u32x2v*)(base + (cb2 >> 5) * 512 + (((cb2 >> 2) & 3) << 4) * 8 + ((cb2 >> 4) & 1) * 4) = (u32x2v){tp[e][2], tp[e][3]}; }
            }
        }
        if (mode & 2) {
            float qg[8], kg[8]; p2_load_gains(F, qg, kg, lane);
#pragma unroll 4
            for (int tt = 0; tt < 8; ++tt) p2_mixb_token<false>(F, PROJ, (size_t)(row0 + tt), b, t0 + tt, 0, tt, qg, kg, lane);
        }
    }
}
__device__ __forceinline__ void p2_sample_pieces(Frame& F) {
    const int gw = F.vcu * NWAVES + F.wave, NGW = F.G * NWAVES, lane = F.lane;
    const bf16* PROJ = WSP(bf16, WS_PROJ);
    for (int r = gw; r < NSB * 16; r += NGW) {
        const int s = r & (NSB - 1), p = r >> 7;
        if (p < 12) {
            const int j = p >> 2, tt0 = 2 * (p & 3), col8 = (lane + 64 * j) * 8;
            float cw[4][8], x[5][8];
#pragma unroll
            for (int i = 0; i < 4; ++i) { const f32x4 a = *(const GAS f32x4*)(F.conv_w + i * CONVC + col8), c = *(const GAS f32x4*)(F.conv_w + i * CONVC + col8 + 4);
                cw[i][0] = a.x; cw[i][1] = a.y; cw[i][2] = a.z; cw[i][3] = a.w; cw[i][4] = c.x; cw[i][5] = c.y; cw[i][6] = c.z; cw[i][7] = c.w; }
#pragma unroll
            for (int k = 0; k < 5; ++k) { const int rr = tt0 - 3 + k;
                if (rr < 0) { const float* sp = F.state_conv + ((size_t)s * 3 + (3 + rr)) * CONVC + col8; const f32x4 a = *(const GAS f32x4*)sp, c = *(const GAS f32x4*)(sp + 4);
                    x[k][0] = a.x; x[k][1] = a.y; x[k][2] = a.z; x[k][3] = a.w; x[k][4] = c.x; x[k][5] = c.y; x[k][6] = c.z; x[k][7] = c.w; }
                else { const v4u w = *(const GAS v4u*)(PROJ + (size_t)(MP + s * 8 + rr) * NPROJ + col8); unpack8(w, x[k]); } }
#pragma unroll
            for (int u = 0; u < 2; ++u) {
                const int tt = tt0 + u; float y[8], ss = 0.f;
#pragma unroll
                for (int e = 0; e < 8; ++e) { const float a = cw[0][e] * x[u][e] + cw[1][e] * x[u + 1][e] + cw[2][e] * x[u + 2][e] + cw[3][e] * x[u + 3][e]; y[e] = silu_f(a); ss += y[e] * y[e]; }
                if (j < 2) {
                    ss += __shfl_xor(ss, 1); ss += __shfl_xor(ss, 2); ss += __shfl_xor(ss, 4); ss += __shfl_xor(ss, 8);
                    const float rn = (1.f / sqrtf(ss + EPS)) * (j == 0 ? 0.08838834764831845f : 1.f);
#pragma unroll
                    for (int e = 0; e < 8; ++e) y[e] *= rn;
                }
                float* o = WSP(float, WS_QKVS) + (size_t)(s * 8 + tt) * CONVC + col8;
                *(GAS f32x4*)o = (f32x4){y[0], y[1], y[2], y[3]}; *(GAS f32x4*)(o + 4) = (f32x4){y[4], y[5], y[6], y[7]};
                if (tt >= 5) { float* co = F.out + O_CS + ((size_t)s * 3 + (tt - 5)) * CONVC + col8;
                    *(GAS f32x4*)co = (f32x4){x[u + 3][0], x[u + 3][1], x[u + 3][2], x[u + 3][3]}; *(GAS f32x4*)(co + 4) = (f32x4){x[u + 3][4], x[u + 3][5], x[u + 3][6], x[u + 3][7]}; }
            }
        } else {
            float qg[8], kg[8]; p2_load_gains(F, qg, kg, lane);
            const int tt0 = 2 * (p - 12);
#pragma unroll
            for (int u = 0; u < 2; ++u) p2_mixb_token<true>(F, PROJ, (size_t)(MP + s * 8 + tt0 + u), 0, 0, s, tt0 + u, qg, kg, lane);
        }
    }
}

constexpr int P3_PAIR = 512 + 64 * 64 * 4;
__device__ __forceinline__ int tswz(int row, int col) { return row * 64 + (col ^ (((row >> 1) & 7) << 3)); }
__device__ __forceinline__ void p3_chunk_prep(Frame& F) {
    const int lane = F.lane, wave = F.wave, pair = wave >> 1, wp = wave & 1, fr = lane & 15, fq = lane >> 4;
    LAS unsigned char* pb = F.lds + pair * P3_PAIR;
    LAS float* Gc = (LAS float*)pb; LAS float* Bt = (LAS float*)(pb + 256); LAS float* LmT = (LAS float*)(pb + 512);
    LAS bf16* TB = (LAS bf16*)(pb + 512); LAS bf16* TG = (LAS bf16*)(pb + 512 + 8192);
    const bf16* QA = WSP(bf16, WS_QA); const bf16* KA = WSP(bf16, WS_KA); const bf16* KAT = WSP(bf16, WS_KAT); const bf16* VAT = WSP(bf16, WS_VAT);
    for (int u0 = F.vcu * 4; u0 < NBH * NCH; u0 += F.G * 4) {
        const int unit = u0 + pair, bh = unit >> 6, n = unit & 63, b = bh >> 2, h = bh & 3, t0 = n * 64;
        const size_t cb = (size_t)bh * NCH + n;
        if (wp == 0) {
            const size_t r = (size_t)(b * SEQ + t0 + lane) * 4 + h;
            float g = WSP(float, WS_GG)[r];
#pragma unroll
            for (int o = 1; o < 64; o <<= 1) { const float up = __shfl_up(g, o); if (lane >= o) g += up; }
            Gc[lane] = g; Bt[lane] = WSP(float, WS_BETA)[r];
            WSP(float, WS_GC)[(size_t)bh * SEQ + t0 + lane] = g;
            WSP(float, WS_CS)[cb * 64 + lane] = __shfl(g, 63);
        }
        __syncthreads();
        {
            const bf16* Xf = (wp ? QA : KA) + (((size_t)bh * (SEQ / 16) + 4 * n) * 4 * 64 + lane) * 8;
            const bf16* Kf = KA + (((size_t)bh * (SEQ / 16) + 4 * n) * 4 * 64 + lane) * 8;
#pragma unroll 1
            for (int it = 0; it < 4; ++it) {
                v4u xf[4], kf[4][4];
#pragma unroll
                for (int ks = 0; ks < 4; ++ks) { xf[ks] = *(const GAS v4u*)(Xf + (size_t)(it * 4 + ks) * 512);
#pragma unroll
                    for (int jt = 0; jt < 4; ++jt) kf[jt][ks] = *(const GAS v4u*)(Kf + (size_t)(jt * 4 + ks) * 512); }
#pragma unroll
                for (int jt = 0; jt < 4; ++jt) {
                    f32x4 acc = (f32x4){0.f, 0.f, 0.f, 0.f};
                    if (jt <= it) {
#pragma unroll
                        for (int ks = 0; ks < 4; ++ks) acc = wp ? mfma16(as_bf16x8(kf[jt][ks]), as_bf16x8(xf[ks]), acc) : mfma16(as_bf16x8(xf[ks]), as_bf16x8(kf[jt][ks]), acc);
                    }
                    if (wp == 0) {
                        if (jt <= it) { const int j = 16 * jt + fr; const float gj = Gc[j]; f32x4 o;
#pragma unroll
                            for (int r = 0; r < 4; ++r) { const int i = 16 * it + 4 * fq + r; o[r] = (i > j) ? acc[r] * Bt[i] * __expf(Gc[i] - gj) : 0.f; }
                            *(LAS f32x4*)(LmT + j * 64 + 16 * it + 4 * fq) = o; }
                    } else {
                        const int i = 16 * it + fr; const float gi = Gc[i]; float v[4];
#pragma unroll
                        for (int r = 0; r < 4; ++r) { const int j = 16 * jt + 4 * fq + r; v[r] = (i >= j) ? acc[r] * __expf(gi - Gc[j]) : 0.f; }
                        *(GAS u32x2v*)(WSP(bf16, WS_QKF) + (((cb * 4 + it) * 2 + (jt >> 1)) * 64 + lane) * 8 + (jt & 1) * 4) = (u32x2v){cvtpk(v[0], v[1]), cvtpk(v[2], v[3])};
                    }
                }
            }
        }
        __syncthreads();
        if (wp == 0) {
            float t[64]; v4u tbv[8], tgv[8];
            int lv = lane; asm volatile("" : "+v"(lv));
#pragma unroll
            for (int c = 0; c < 64; ++c) t[c] = (c == lv) ? 1.f : 0.f;
#define P3_SOLVE_BLOCK(JB) _Pragma("unroll 1") for (int j = 16 * (JB); j < 16 * (JB) + 16; ++j) { \
                const float lraw = LmT[j * 64 + lane]; const float nl = (lane > j) ? -lraw : 0.f; \
                _Pragma("unroll") for (int c = 0; c < 16 * ((JB) + 1); ++c) { const float s = __uint_as_float(__builtin_amdgcn_readlane(__float_as_uint(t[c]), j)); t[c] = fmaf(nl, s, t[c]); } }
            P3_SOLVE_BLOCK(0) P3_SOLVE_BLOCK(1) P3_SOLVE_BLOCK(2) P3_SOLVE_BLOCK(3)
#undef P3_SOLVE_BLOCK
#pragma unroll
            for (int c8 = 0; c8 < 8; ++c8) {
                const f32x4 b0 = *(const LAS f32x4*)(Bt + 8 * c8), b1 = *(const LAS f32x4*)(Bt + 8 * c8 + 4), g0 = *(const LAS f32x4*)(Gc + 8 * c8), g1 = *(const LAS f32x4*)(Gc + 8 * c8 + 4);
                float o[8], og[8];
#pragma unroll
                for (int e = 0; e < 8; ++e) { const float be = (e < 4) ? b0[e & 3] : b1[e & 3], ge = (e < 4) ? g0[e & 3] : g1[e & 3]; o[e] = t[8 * c8 + e] * be; og[e] = o[e] * __expf(ge); }
                tbv[c8] = pack8(o); tgv[c8] = pack8(og);
            }
            asm volatile("s_waitcnt lgkmcnt(0)" ::: "memory");
#pragma unroll
            for (int c8 = 0; c8 < 8; ++c8) { *(LAS v4u*)(TB + tswz(lane, 8 * c8)) = tbv[c8]; *(LAS v4u*)(TG + tswz(lane, 8 * c8)) = tgv[c8]; }
        }
        __syncthreads();
#pragma unroll 1
        for (int q4 = 0; q4 < 4; ++q4) {
            const int q = wp + 2 * q4;
            v4u vb[2], ka[2];
#pragma unroll
            for (int ks = 0; ks < 2; ++ks) {
                vb[ks] = *(const GAS v4u*)(VAT + (((cb * 8 + q) * 2 + ks) * 64 + lane) * 8);
                ka[ks] = *(const GAS v4u*)(KAT + (((cb * 8 + q) * 2 + ks) * 64 + lane) * 8); }
#pragma unroll
            for (int ct = 0; ct < 4; ++ct) {
                f32x4 au = (f32x4){0.f, 0.f, 0.f, 0.f}, aw = au;
#pragma unroll
                for (int ks = 0; ks < 2; ++ks) { const int row = 16 * ct + fr;
                    const u32x2v a0 = *(const LAS u32x2v*)(TB + tswz(row, 32 * ks + 4 * fq)), a1 = *(const LAS u32x2v*)(TB + tswz(row, 32 * ks + 16 + 4 * fq));
                    const u32x2v b0 = *(const LAS u32x2v*)(TG + tswz(row, 32 * ks + 4 * fq)), b1 = *(const LAS u32x2v*)(TG + tswz(row, 32 * ks + 16 + 4 * fq));
                    au = mfma16(as_bf16x8((v4u){a0.x, a0.y, a1.x, a1.y}), as_bf16x8(vb[ks]), au);
                    aw = mfma16(as_bf16x8(ka[ks]), as_bf16x8((v4u){b0.x, b0.y, b1.x, b1.y}), aw); }
                *(GAS f32x4*)(WSP(float, WS_UF) + (((cb * 8 + q) * 4 + ct) * 64 + lane) * 4) = au;
                *(GAS u32x2v*)(WSP(bf16, WS_WF) + (((cb * 4 + ct) * 4 + (q >> 1)) * 64 + lane) * 8 + (q & 1) * 4) = (u32x2v){cvtpk(aw[0], aw[1]), cvtpk(aw[2], aw[3])};
            }
        }
        __syncthreads();
    }
}

constexpr int P4_SB = 0, P4_VN = 8192, P4_END = 8192 + 8192;
struct ScanOps { v4u wf[4]; v4u qf[4]; v4u qk[2]; f32x4 u; v4u kf[2][2]; f32x4 gc; float gl; };
#define GLD(T, sbase, voff, imm) (*(const GAS T*)((const GAS unsigned char*)(sbase) + (voff) + (imm)))
__device__ __forceinline__ void p4_scan_load(Frame& F, ScanOps& o, int bh, int n, int vt, int ct, int lane) {
    const unsigned fr = lane & 15, fq = lane >> 4; const size_t cb = (size_t)bh * NCH + n;
    const unsigned char* wb = F.ws + WS_WF + ((cb * 4 + ct) * 4) * 1024;
    const unsigned char* qb = F.ws + WS_QA + (((size_t)bh * (SEQ / 16) + 4 * n + ct) * 4) * 1024;
    const unsigned char* qkb = F.ws + WS_QKF + ((cb * 4 + ct) * 2) * 1024;
    const unsigned char* kb0 = F.ws + WS_KAT + ((cb * 8 + 2 * ct) * 2) * 1024;
    const unsigned char* kb1 = kb0 + 2048;
    const unsigned char* ub = F.ws + WS_UF + (((cb * 8 + vt) * 4 + ct) * 64) * 16;
    const unsigned char* gb = F.ws + WS_GC + ((size_t)bh * SEQ + 64 * n + 16 * ct) * 4;
    const unsigned l16 = lane * 16u;
#pragma unroll
    for (int ks = 0; ks < 4; ++ks) { o.wf[ks] = GLD(v4u, wb, l16, ks * 1024); o.qf[ks] = GLD(v4u, qb, l16, ks * 1024); }
#pragma unroll
    for (int ks = 0; ks < 2; ++ks) { o.qk[ks] = GLD(v4u, qkb, l16, ks * 1024); o.kf[0][ks] = GLD(v4u, kb0, l16, ks * 1024); o.kf[1][ks] = GLD(v4u, kb1, l16, ks * 1024); }
    o.u = GLD(f32x4, ub, l16, 0);
    o.gc = GLD(f32x4, gb, fq * 16u, 0);
    o.gl = GLD(float, F.ws + WS_CS + cb * 256, lane * 4u, 0);
}
#define LDS_BARRIER() asm volatile("s_waitcnt lgkmcnt(0)\n\ts_barrier" ::: "memory")
__device__ __forceinline__ void p4_scan_step(Frame& F, const ScanOps& cur, f32x4 (&S)[2], LAS unsigned char* SB, LAS unsigned char* VN, int n, int b, int h, int vt, int ct, int lane) {
    const int fr = lane & 15, fq = lane >> 4;
#pragma unroll
    for (int ki = 0; ki < 2; ++ki) *(LAS u32x2v*)(SB + (ct * 64 + lane) * 16 + ki * 8) = (u32x2v){cvtpk(S[ki][0], S[ki][1]), cvtpk(S[ki][2], S[ki][3])};
    LDS_BARRIER();
    f32x4 t1 = (f32x4){0.f, 0.f, 0.f, 0.f}, o1 = (f32x4){0.f, 0.f, 0.f, 0.f};
#pragma unroll
    for (int ks = 0; ks < 4; ++ks) { const bf16x8 sb = as_bf16x8(*(const LAS v4u*)(SB + (ks * 64 + lane) * 16));
        t1 = mfma16(as_bf16x8(cur.wf[ks]), sb, t1);
        o1 = mfma16(as_bf16x8(cur.qf[ks]), sb, o1); }
    f32x4 vn, vs;
#pragma unroll
    for (int r = 0; r < 4; ++r) { vn[r] = cur.u[r] - t1[r]; vs[r] = vn[r] * __expf(cur.gl - cur.gc[r]); }
    *(LAS u32x2v*)(VN + ((0 * 2 + (ct >> 1)) * 64 + lane) * 16 + (ct & 1) * 8) = (u32x2v){cvtpk(vn[0], vn[1]), cvtpk(vn[2], vn[3])};
    *(LAS u32x2v*)(VN + ((1 * 2 + (ct >> 1)) * 64 + lane) * 16 + (ct & 1) * 8) = (u32x2v){cvtpk(vs[0], vs[1]), cvtpk(vs[2], vs[3])};
    LDS_BARRIER();
    f32x4 o2 = (f32x4){0.f, 0.f, 0.f, 0.f};
    const float egl = __expf(cur.gl);
    S[0] = S[0] * egl; S[1] = S[1] * egl;
#pragma unroll
    for (int ks = 0; ks < 2; ++ks) { const bf16x8 vnb = as_bf16x8(*(const LAS v4u*)(VN + ((0 * 2 + ks) * 64 + lane) * 16)), vsb = as_bf16x8(*(const LAS v4u*)(VN + ((1 * 2 + ks) * 64 + lane) * 16));
        o2 = mfma16(as_bf16x8(cur.qk[ks]), vnb, o2);
        S[0] = mfma16(as_bf16x8(cur.kf[0][ks]), vsb, S[0]); S[1] = mfma16(as_bf16x8(cur.kf[1][ks]), vsb, S[1]); }
    float* oa = WSP(float, WS_OA) + (size_t)(b * SEQ + 64 * n + 16 * ct + 4 * fq) * WA + h * DA + 16 * vt + fr;
#pragma unroll
    for (int r = 0; r < 4; ++r) oa[(size_t)r * WA] = __expf(cur.gc[r]) * o1[r] + o2[r];
}
__device__ __forceinline__ void p4_scan(Frame& F, int unit) {
    const int lane = F.lane, wave = F.wave, fr = lane & 15, fq = lane >> 4;
    const int bh = unit >> 2, vq = unit & 3, vtl = wave >> 2, ct = wave & 3, vt = 2 * vq + vtl, b = bh >> 2, h = bh & 3;
    LAS unsigned char* SB = F.lds + P4_SB + vtl * 4096;
    LAS unsigned char* VN = F.lds + P4_VN + vtl * 4096;
    f32x4 S[2] = {(f32x4){0.f, 0.f, 0.f, 0.f}, (f32x4){0.f, 0.f, 0.f, 0.f}};
    ScanOps A, B;
    p4_scan_load(F, A, bh, 0, vt, ct, lane);
#pragma unroll 1
    for (int n = 0; n < NCH; n += 2) {
#ifdef SCAN_NOLOAD
        if (n == 0) p4_scan_load(F, B, bh, n + 1, vt, ct, lane);
        p4_scan_step(F, A, S, SB, VN, n, b, h, vt, ct, lane);
        p4_scan_step(F, B, S, SB, VN, n + 1, b, h, vt, ct, lane);
#else
        p4_scan_load(F, B, bh, n + 1, vt, ct, lane);
        p4_scan_step(F, A, S, SB, VN, n, b, h, vt, ct, lane);
        p4_scan_load(F, A, bh, (n + 2 < NCH) ? n + 2 : n, vt, ct, lane);
        p4_scan_step(F, B, S, SB, VN, n + 1, b, h, vt, ct, lane);
#endif
    }
#pragma unroll
    for (int ki = 0; ki < 2; ++ki)
#pragma unroll
        for (int r = 0; r < 4; ++r) F.out[O_DP + ((size_t)bh * DA + 16 * (2 * ct + ki) + 4 * fq + r) * DA + 16 * vt + fr] = S[ki][r];
    __syncthreads();
}

constexpr int P4B_QKV = 16384, P4B_RED = P4B_QKV + 8 * 3 * 128 * 4, P4B_SC = P4B_RED + 2 * 4 * 128 * 4;
__device__ __forceinline__ void p4b_sample_delta(Frame& F, int unit) {
    const int tid = F.tid, s = unit >> 2, h = unit & 3, kq = tid >> 7, v = tid & 127;
    LAS float* qkv = (LAS float*)(F.lds + P4B_QKV); LAS float* red = (LAS float*)(F.lds + P4B_RED); LAS float* sc = (LAS float*)(F.lds + P4B_SC);
    for (int i = tid; i < 8 * 3 * 128; i += NWAVES * 64) { const int t = i / 384, r = i % 384, th = r >> 7, d = r & 127; qkv[i] = WSP(float, WS_QKVS)[(size_t)(s * 8 + t) * CONVC + th * 512 + h * DA + d]; }
    if (tid < 16) { const int t = tid & 7; const size_t r = (size_t)(MP + s * 8 + t) * 4 + h; sc[tid] = (tid < 8) ? WSP(float, WS_BETA)[r] : __expf(WSP(float, WS_GG)[r]); }
    float S[32];
    const float* sp = F.state_delta + ((size_t)(s * HA + h) * DA + 32 * kq) * DA + v;
#pragma unroll
    for (int i = 0; i < 32; ++i) S[i] = sp[(size_t)i * DA];
    __syncthreads();
#pragma unroll 1
    for (int t = 0; t < 8; ++t) {
        const LAS float* qt = qkv + t * 384 + 32 * kq; const LAS float* kt = qt + 128; const float beta = sc[t], dec = sc[8 + t];
        float part = 0.f;
#pragma unroll
        for (int i = 0; i < 32; ++i) { S[i] *= dec; part += kt[i] * S[i]; }
        red[kq * 128 + v] = part;
        __syncthreads();
        const float ks = (red[v] + red[128 + v]) + (red[256 + v] + red[384 + v]);
        const float vn = beta * (qkv[t * 384 + 256 + v] - ks);
        float po = 0.f;
#pragma unroll
        for (int i = 0; i < 32; ++i) { S[i] += kt[i] * vn; po += qt[i] * S[i]; }
        red[512 + kq * 128 + v] = po;
        __syncthreads();
        if (kq == 0) WSP(float, WS_OA)[(size_t)(MP + s * 8 + t) * WA + h * DA + v] = (red[512 + v] + red[640 + v]) + (red[768 + v] + red[896 + v]);
    }
    float* dp = F.out + O_DS + ((size_t)(s * HA + h) * DA + 32 * kq) * DA + v;
#pragma unroll
    for (int i = 0; i < 32; ++i) dp[(size_t)i * DA] = S[i];
    __syncthreads();
}

struct AttnKV { v4u kf[2][2], vr[4]; };
constexpr int P4C_VPITCH = 160, P4C_VBUF = 32 * P4C_VPITCH;
typedef short v4i16_t __attribute__((ext_vector_type(4)));
__device__ __forceinline__ void p4c_load(Frame& F, AttnKV& o, size_t hbase, int c, int kc, int lane) {
    const unsigned char* kb = F.ws + WS_K16 + (((hbase * 16 + c) * 256 + 32 * kc) * DB) * 2;
    const unsigned char* vb = F.ws + WS_VT16 + (((hbase * 16 + c) * 256 + 32 * kc) * DB) * 2;
    const unsigned fr = lane & 15, fq = lane >> 4, koff = fr * 128u + fq * 16u, l16 = lane * 16u;
#pragma unroll
    for (int kt = 0; kt < 2; ++kt)
#pragma unroll
        for (int ks = 0; ks < 2; ++ks) o.kf[kt][ks] = GLD(v4u, kb, koff, kt * 2048 + ks * 64);
#pragma unroll
    for (int m = 0; m < 4; ++m) o.vr[m] = GLD(v4u, vb, l16, m * 1024);
}
__device__ __forceinline__ float xq_max(float v) {
    { const auto r = __builtin_amdgcn_permlane16_swap(__float_as_uint(v), __float_as_uint(v), false, false); v = fmaxf(__uint_as_float(r[0]), __uint_as_float(r[1])); }
    { const auto r = __builtin_amdgcn_permlane32_swap(__float_as_uint(v), __float_as_uint(v), false, false); v = fmaxf(__uint_as_float(r[0]), __uint_as_float(r[1])); }
    return v;
}
__device__ __forceinline__ float xq_sum(float v) {
    { const auto r = __builtin_amdgcn_permlane16_swap(__float_as_uint(v), __float_as_uint(v), false, false); v = __uint_as_float(r[0]) + __uint_as_float(r[1]); }
    { const auto r = __builtin_amdgcn_permlane32_swap(__float_as_uint(v), __float_as_uint(v), false, false); v = __uint_as_float(r[0]) + __uint_as_float(r[1]); }
    return v;
}
constexpr int P4C_NQS = 2;
__device__ __forceinline__ void p4c_chunk(const AttnKV& kv, LAS unsigned char* vlds, const v4u (&qf)[P4C_NQS][2], f32x4 (&O)[P4C_NQS][4], float (&mrow)[P4C_NQS], float (&lrow)[P4C_NQS], int i0, int dc, int span, int lag, int kc, int fr, int fq) {
    const float m4 = ((dc & 3) == 0) ? 1.f : 0.f, m16 = (dc == 0) ? 1.f : 0.f;
    v4u vf[4];
    {
        const int lane = fq * 16 + fr;
#pragma unroll
        for (int m = 0; m < 4; ++m) { const int p = lane + 64 * m; *(LAS v4u*)(vlds + (p >> 3) * P4C_VPITCH + (p & 7) * 16) = kv.vr[m]; }
#pragma unroll
        for (int dt = 0; dt < 4; ++dt) {
            const LAS unsigned char* a0 = vlds + (4 * fq + (fr >> 2)) * P4C_VPITCH + (16 * dt + 4 * (fr & 3)) * 2;
            const v4i16_t t0 = __builtin_amdgcn_ds_read_tr16_b64_v4i16((LAS v4i16_t*)a0), t1 = __builtin_amdgcn_ds_read_tr16_b64_v4i16((LAS v4i16_t*)(a0 + 16 * P4C_VPITCH));
            const u32x2v u0 = __builtin_bit_cast(u32x2v, t0), u1 = __builtin_bit_cast(u32x2v, t1);
            vf[dt] = (v4u){u0.x, u0.y, u1.x, u1.y};
        }
    }
#pragma unroll
    for (int qs = 0; qs < P4C_NQS; ++qs) {
        const int iqlo = i0 + 16 * qs, iqhi = iqlo + 15;
        if (32 * kc > iqhi - lag || 32 * kc + 31 < iqlo - span) continue;
        f32x4 s0 = (f32x4){0.f, 0.f, 0.f, 0.f}, s1 = s0;
#pragma unroll
        for (int ks = 0; ks < 2; ++ks) { s0 = mfma16(as_bf16x8(kv.kf[0][ks]), as_bf16x8(qf[qs][ks]), s0); s1 = mfma16(as_bf16x8(kv.kf[1][ks]), as_bf16x8(qf[qs][ks]), s1); }
        const int dl0 = 16 * (iqlo + fr - 32 * kc - 4 * fq) + dc;
        float cn[8], sv[8]; float mx = mrow[qs];
#pragma unroll
        for (int e = 0; e < 8; ++e) {
            const unsigned dl = (unsigned)(dl0 - 16 * (16 * (e >> 2) + (e & 3)));
            const float cnt = ((dl <= 128u) ? 1.f : 0.f) + ((dl <= 512u) ? m4 : 0.f) + ((dl <= 2048u) ? m16 : 0.f);
            cn[e] = cnt; const float sc = (e < 4) ? s0[e & 3] : s1[e & 3]; sv[e] = (cnt > 0.f) ? sc : -1e30f; mx = fmaxf(mx, sv[e]);
        }
        mx = xq_max(mx);
        if (!__all(mx == mrow[qs])) {
            const float alpha = exp2f(mrow[qs] - mx); mrow[qs] = mx; lrow[qs] *= alpha;
#pragma unroll
            for (int dt = 0; dt < 4; ++dt) O[qs][dt] = O[qs][dt] * alpha;
        }
        float p[8], ps = 0.f;
#pragma unroll
        for (int e = 0; e < 8; ++e) { p[e] = cn[e] * exp2f(sv[e] - mx); ps += p[e]; }
        lrow[qs] += ps;
        const bf16x8 pb = as_bf16x8((v4u){cvtpk(p[0], p[1]), cvtpk(p[2], p[3]), cvtpk(p[4], p[5]), cvtpk(p[6], p[7])});
#pragma unroll
        for (int dt = 0; dt < 4; ++dt) O[qs][dt] = mfma16(as_bf16x8(vf[dt]), pb, O[qs][dt]);
    }
}
__device__ __forceinline__ void p4c_range(int c0, int i0, int c, int& dc, int& span, int& lag, int& lo, int& hi) {
    dc = c0 - c; const int wmax = (dc == 0) ? 2048 : ((dc & 3) == 0 ? 512 : 128);
    span = (wmax - dc) >> 4; lag = (dc < 0) ? 1 : 0;
    int ikmin = i0 - span; if (ikmin < 0) ikmin = 0;
    lo = ikmin >> 5; hi = (i0 + 16 * P4C_NQS - 1 - lag) >> 5;
}
__device__ __forceinline__ void p4c_attn_prompt(Frame& F, int job) {
    const int lane = F.lane, fr = lane & 15, fq = lane >> 4;
    const int qb = job & (16 / P4C_NQS - 1), jr = job / (16 / P4C_NQS), c0 = jr & 15, hb = (jr >> 4) & 7, b = jr >> 7, i0 = 16 * P4C_NQS * qb;
    const size_t hbase = (size_t)b * HB + hb;
    const bf16* Q16 = WSP(bf16, WS_Q16) + ((hbase * 16 + c0) * 256) * DB;
    v4u qf[P4C_NQS][2];
#pragma unroll
    for (int qs = 0; qs < P4C_NQS; ++qs)
#pragma unroll
        for (int ks = 0; ks < 2; ++ks) qf[qs][ks] = *(const GAS v4u*)(Q16 + (size_t)(i0 + 16 * qs + fr) * DB + 32 * ks + 8 * fq);
    f32x4 O[P4C_NQS][4]; float mrow[P4C_NQS], lrow[P4C_NQS];
#pragma unroll
    for (int qs = 0; qs < P4C_NQS; ++qs) { mrow[qs] = -1e30f; lrow[qs] = 0.f;
#pragma unroll
        for (int dt = 0; dt < 4; ++dt) O[qs][dt] = (f32x4){0.f, 0.f, 0.f, 0.f}; }
    int c = 0, dc, span, lag, lo, hi; p4c_range(c0, i0, 0, dc, span, lag, lo, hi);
    int kc = lo;
    AttnKV A, B;
    LAS unsigned char* vlds = F.lds + F.wave * P4C_VBUF;
    p4c_load(F, A, hbase, c, kc, lane);
#pragma unroll 1
    for (;;) {
        int nc = c, nkc = kc + 1, ndc = dc, nspan = span, nlag = lag, nlo = lo, nhi = hi;
        if (nkc > hi) { nc = c + 1; if (nc < 16) { p4c_range(c0, i0, nc, ndc, nspan, nlag, nlo, nhi); nkc = nlo; } }
#ifndef ATTN_NOLOAD
        if (nc < 16) p4c_load(F, B, hbase, nc, nkc, lane);
#else
        B = A;
#endif
        p4c_chunk(A, vlds, qf, O, mrow, lrow, i0, dc, span, lag, kc, fr, fq);
        if (nc >= 16) break;
        c = nc; kc = nkc; dc = ndc; span = nspan; lag = nlag; lo = nlo; hi = nhi;
        nc = c; nkc = kc + 1;
        if (nkc > hi) { nc = c + 1; if (nc < 16) { p4c_range(c0, i0, nc, ndc, nspan, nlag, nlo, nhi); nkc = nlo; } }
#ifndef ATTN_NOLOAD
        if (nc < 16) p4c_load(F, A, hbase, nc, nkc, lane);
#else
        A = B;
#endif
        p4c_chunk(B, vlds, qf, O, mrow, lrow, i0, dc, span, lag, kc, fr, fq);
        if (nc >= 16) break;
        c = nc; kc = nkc; dc = ndc; span = nspan; lag = nlag; lo = nlo; hi = nhi;
    }
#pragma unroll
    for (int qs = 0; qs < P4C_NQS; ++qs) {
        const float inv = 1.f / xq_sum(lrow[qs]);
        const int t = c0 + 16 * (i0 + 16 * qs + fr);
        bf16* o = WSP(bf16, WS_MIX) + (size_t)(b * SEQ + t) * D + WA + hb * DB + 4 * fq;
#pragma unroll
        for (int dt = 0; dt < 4; ++dt) *(GAS u32x2v*)(o + 16 * dt) = (u32x2v){cvtpk(O[qs][dt][0] * inv, O[qs][dt][1] * inv), cvtpk(O[qs][dt][2] * inv, O[qs][dt][3] * inv)};
    }
}

constexpr int P4D_PART = 32768;
__device__ __forceinline__ void p4d_rowptr(Frame& F, int s, int ch, int kk, const float*& kp, const float*& vp, int& pos) {
    if (ch < 24) { const int rho = 64 * ch + 16 * (kk >> 3) + (kk & 7); pos = rho; kp = F.cache_k + ((size_t)s * WBUF + rho) * WB; vp = F.cache_v + ((size_t)s * WBUF + rho) * WB; }
    else if (ch < 40) { const int rho = 1536 + 32 * (ch - 24) + kk; pos = rho; kp = F.cache_k + ((size_t)s * WBUF + rho) * WB; vp = F.cache_v + ((size_t)s * WBUF + rho) * WB; }
    else { const int tq = kk & 7; pos = (kk < 8) ? WBUF + tq : 1 << 20; kp = F.out + O_KS + (size_t)(s * 8 + tq) * WB; vp = F.out + O_VS + (size_t)(s * 8 + tq) * WB; }
}
__device__ __forceinline__ void p4d_attn_sample(Frame& F, int unit) {
    const int lane = F.lane, wave = F.wave, fr = lane & 15, fq = lane >> 4;
    const int s = unit >> 2, hb = (unit & 3) * 2 + (wave >> 2), qtr = wave & 3;
    v4u qf[2];
#pragma unroll
    for (int ks = 0; ks < 2; ++ks) {
        if (fr < 8) { const float* qp = WSP(float, WS_QSB) + ((size_t)(s * 8 + fr) * HB + hb) * DB + 32 * ks + 8 * fq; const f32x4 a = *(const f32x4*)qp, c = *(const f32x4*)(qp + 4);
            qf[ks] = (v4u){cvtpk(a.x, a.y), cvtpk(a.z, a.w), cvtpk(c.x, c.y), cvtpk(c.z, c.w)}; }
        else qf[ks] = (v4u){0u, 0u, 0u, 0u};
    }
    f32x4 O[4]; float mrow = -1e30f, lrow = 0.f;
#pragma unroll
    for (int dt = 0; dt < 4; ++dt) O[dt] = (f32x4){0.f, 0.f, 0.f, 0.f};
#pragma unroll 1
    for (int ch = qtr; ch < 41; ch += 4) {
        f32x4 kr[2][2][2];
#pragma unroll
        for (int kt = 0; kt < 2; ++kt) { const float* kp; const float* vp; int pos; p4d_rowptr(F, s, ch, 16 * kt + fr, kp, vp, pos);
#pragma unroll
            for (int ks = 0; ks < 2; ++ks) { kr[kt][ks][0] = *(const f32x4*)(kp + hb * DB + 32 * ks + 8 * fq); kr[kt][ks][1] = *(const f32x4*)(kp + hb * DB + 32 * ks + 8 * fq + 4); } }
        float vr[4][8];
#pragma unroll
        for (int jj = 0; jj < 8; ++jj) { const float* kp; const float* vp; int pos; p4d_rowptr(F, s, ch, 16 * (jj >> 2) + 4 * fq + (jj & 3), kp, vp, pos);
#pragma unroll
            for (int dt = 0; dt < 4; ++dt) vr[dt][jj] = vp[hb * DB + 16 * dt + fr]; }
        f32x4 s0 = (f32x4){0.f, 0.f, 0.f, 0.f}, s1 = s0;
#pragma unroll
        for (int ks = 0; ks < 2; ++ks) {
            const v4u k0 = (v4u){cvtpk(kr[0][ks][0].x, kr[0][ks][0].y), cvtpk(kr[0][ks][0].z, kr[0][ks][0].w), cvtpk(kr[0][ks][1].x, kr[0][ks][1].y), cvtpk(kr[0][ks][1].z, kr[0][ks][1].w)};
            const v4u k1 = (v4u){cvtpk(kr[1][ks][0].x, kr[1][ks][0].y), cvtpk(kr[1][ks][0].z, kr[1][ks][0].w), cvtpk(kr[1][ks][1].x, kr[1][ks][1].y), cvtpk(kr[1][ks][1].z, kr[1][ks][1].w)};
            s0 = mfma16(as_bf16x8(k0), as_bf16x8(qf[ks]), s0); s1 = mfma16(as_bf16x8(k1), as_bf16x8(qf[ks]), s1);
        }
        const int qpos = WBUF + fr;
        float cn[8], sv[8]; float mx = mrow;
#pragma unroll
        for (int e = 0; e < 8; ++e) {
            const float* kp; const float* vp; int pos; p4d_rowptr(F, s, ch, 16 * (e >> 2) + 4 * fq + (e & 3), kp, vp, pos);
            const int dl = qpos - pos;
            float cnt = 0.f;
            if (dl >= 0 && fr < 8) { cnt = (dl <= 128) ? 1.f : 0.f; if ((dl & 3) == 0 && dl <= 512) cnt += 1.f; if ((dl & 15) == 0 && dl <= 2048) cnt += 1.f; }
            cn[e] = cnt; const float sc = (e < 4) ? s0[e & 3] : s1[e & 3]; sv[e] = (cnt > 0.f) ? sc : -1e30f; mx = fmaxf(mx, sv[e]);
        }
        mx = fmaxf(mx, __shfl_xor(mx, 16)); mx = fmaxf(mx, __shfl_xor(mx, 32));
        const float alpha = exp2f(mrow - mx); mrow = mx;
        float p[8], ps = 0.f;
#pragma unroll
        for (int e = 0; e < 8; ++e) { p[e] = cn[e] * exp2f(sv[e] - mx); ps += p[e]; }
        ps += __shfl_xor(ps, 16); ps += __shfl_xor(ps, 32);
        lrow = lrow * alpha + ps;
        const bf16x8 pb = as_bf16x8((v4u){cvtpk(p[0], p[1]), cvtpk(p[2], p[3]), cvtpk(p[4], p[5]), cvtpk(p[6], p[7])});
#pragma unroll
        for (int dt = 0; dt < 4; ++dt) { const v4u va = (v4u){cvtpk(vr[dt][0], vr[dt][1]), cvtpk(vr[dt][2], vr[dt][3]), cvtpk(vr[dt][4], vr[dt][5]), cvtpk(vr[dt][6], vr[dt][7])};
            O[dt] = O[dt] * alpha; O[dt] = mfma16(as_bf16x8(va), pb, O[dt]); }
    }
    LAS float* part = (LAS float*)(F.lds + P4D_PART);
    if (fr < 8) {
        LAS float* pp = part + (wave * 8 + fr) * 66;
#pragma unroll
        for (int dt = 0; dt < 4; ++dt)
#pragma unroll
            for (int r = 0; r < 4; ++r) pp[16 * dt + 4 * fq + r] = O[dt][r];
        if (fq == 0) { pp[64] = mrow; pp[65] = lrow; }
    }
    __syncthreads();
    for (int i = F.tid; i < 2 * 8 * 64; i += NWAVES * 64) {
        const int hh = i >> 9, q = (i >> 6) & 7, d = i & 63;
        float m = -1e30f;
#pragma unroll
        for (int w = 0; w < 4; ++w) m = fmaxf(m, part[((hh * 4 + w) * 8 + q) * 66 + 64]);
        float num = 0.f, den = 0.f;
#pragma unroll
        for (int w = 0; w < 4; ++w) { const LAS float* pp = part + ((hh * 4 + w) * 8 + q) * 66; const float sc = exp2f(pp[64] - m); num += sc * pp[d]; den += sc * pp[65]; }
        const int hq = (unit & 3) * 2 + hh;
        WSP(bf16, WS_MIX)[(size_t)(MP + s * 8 + q) * D + WA + hq * DB + d] = (bf16)(cvtpk(num / den, 0.f) & 0xffffu);
    }
    __syncthreads();
}

__device__ __forceinline__ void p5_gate(Frame& F) {
    const int gw = F.vcu * NWAVES + F.wave, NGW = F.G * NWAVES, lane = F.lane, col8 = lane * 8, dim8 = (lane & 15) * 8;
    float dg[8];
    { const f32x4 a = *(const f32x4*)(F.dng + dim8), c = *(const f32x4*)(F.dng + dim8 + 4); dg[0] = a.x; dg[1] = a.y; dg[2] = a.z; dg[3] = a.w; dg[4] = c.x; dg[5] = c.y; dg[6] = c.z; dg[7] = c.w; }
    for (int m = gw; m < M; m += NGW) {
        const float* op = WSP(float, WS_OA) + (size_t)m * WA + col8;
        const f32x4 a = *(const GAS f32x4*)op, c = *(const GAS f32x4*)(op + 4);
        float o[8] = {a.x, a.y, a.z, a.w, c.x, c.y, c.z, c.w}, z[8];
        { const v4u w = *(const GAS v4u*)(WSP(bf16, WS_PROJ) + (size_t)m * NPROJ + PC_Z + col8); unpack8(w, z); }
        float ss = 0.f;
#pragma unroll
        for (int e = 0; e < 8; ++e) ss += o[e] * o[e];
        ss += __shfl_xor(ss, 1); ss += __shfl_xor(ss, 2); ss += __shfl_xor(ss, 4); ss += __shfl_xor(ss, 8);
        const float r = 1.f / sqrtf(ss * (1.f / DA) + EPS);
#pragma unroll
        for (int e = 0; e < 8; ++e) o[e] = o[e] * r * dg[e] * silu_f(z[e]);
        *(GAS v4u*)(WSP(bf16, WS_MIX) + (size_t)m * D + col8) = pack8(o);
    }
}
__device__ __forceinline__ void p7_norm2(Frame& F) {
    const int gw = F.vcu * NWAVES + F.wave, NGW = F.G * NWAVES;
    f32x4 g2[4];
#pragma unroll
    for (int j = 0; j < 4; ++j) g2[j] = *((const f32x4*)F.norm2_g + F.lane + 64 * j);
    for (int m = gw; m < M; m += NGW) {
        const GAS f32x4* xr = (const GAS f32x4*)(F.out + (size_t)m * D) + F.lane;
        f32x4 v[4]; float s = 0.f;
#pragma unroll
        for (int j = 0; j < 4; ++j) { v[j] = xr[64 * j]; s += (v[j].x * v[j].x + v[j].y * v[j].y) + (v[j].z * v[j].z + v[j].w * v[j].w); }
        const float rstd = 1.f / sqrtf(wave_sum(s) * (1.f / D) + EPS);
        GAS unsigned long long* o8 = (GAS unsigned long long*)(WSP(bf16, WS_XN) + (size_t)m * D) + F.lane;
#pragma unroll
        for (int j = 0; j < 4; ++j) { v[j] = v[j] * rstd * g2[j]; o8[64 * j] = (unsigned long long)cvtpk(v[j].x, v[j].y) | ((unsigned long long)cvtpk(v[j].z, v[j].w) << 32); }
    }
}


constexpr int N_PHASES = 10;
#ifndef PH_LIMIT
#define PH_LIMIT 10
#endif
struct Args { const float* in[18]; float* out; unsigned char* ws; int ph_lo, ph_hi; };
__global__ void __launch_bounds__(NWAVES * 64, 2) hymba_fwd(Args args) {
    extern __shared__ __attribute__((aligned(16))) unsigned char lds[];
    Frame F;
    F.lds = (LAS unsigned char*)lds;
    F.MISC = (volatile LAS unsigned*)(F.lds + MISC_OFF);
    F.tid = threadIdx.x; F.lane = F.tid & 63; F.wave = __builtin_amdgcn_readfirstlane(F.tid >> 6);
    F.G = gridDim.x; { const int bx = blockIdx.x; F.vcu = (F.G % 8 == 0) ? (bx % 8) * (F.G / 8) + bx / 8 : bx; }
    F.ws = args.ws; F.out = args.out; F.ctl = (gu32*)(args.ws + WS_CTL);
    F.xp = args.in[0]; F.xs = args.in[1]; F.cache_k = args.in[2]; F.cache_v = args.in[3]; F.state_delta = args.in[4]; F.state_conv = args.in[5]; F.norm1_g = args.in[6]; F.w_in = args.in[7];
    F.conv_w = args.in[8]; F.a_log = args.in[9]; F.dt_bias = args.in[10]; F.dng = args.in[11]; F.qng = args.in[12]; F.kng = args.in[13]; F.w_o = args.in[14]; F.norm2_g = args.in[15]; F.w_up = args.in[16]; F.w_down = args.in[17];
    for (int u = F.tid; u < (LDS_BYTES - LDSCTL_OFF) / 4; u += NWAVES * 64) ((LAS unsigned*)(F.lds + LDSCTL_OFF))[u] = 0u;
    __syncthreads();
#if MK_ONE_LAUNCH
    XcdBarrier bar = xcd_barrier_post((unsigned*)(F.ctl + CW_BAR), F.MISC + 8);
#define GRID_BAR() xcd_barrier(bar)
#else
#define GRID_BAR() do {} while (0)
#endif
    const int lo = args.ph_lo, hi = args.ph_hi;
#ifdef STAMP_A
    volatile LAS unsigned long long* stamps = (volatile LAS unsigned long long*)(F.lds + LDSCTL_OFF);
#define STAMP(k) do { if (F.tid == 0) stamps[k] = __builtin_amdgcn_s_memrealtime(); } while (0)
#else
#define STAMP(k) do {} while (0)
#endif
    STAMP(0);
#ifndef REP_PHASE
#define REP_PHASE -1
#endif
#ifndef REP_P4
#define REP_P4 0
#endif
#define NREP(k) ((REP_PHASE == (k)) ? 2 : 1)
#ifndef P2_REPMODE
#define P2_REPMODE 3
#endif
#define IN(k) (lo <= (k) && (k) < hi)
#define BOTH(k) (IN(k) && IN((k) + 1))

    if (IN(0)) { _Pragma("nounroll") for (int rep = 0; rep < NREP(0); ++rep) { p0_prologue(F); if (BOTH(0)) GRID_BAR(); STAMP(1); } }
    if (IN(1)) {
        pg8::Gemm g{WSP(bf16, WS_XN), WSP(bf16, WS_WIN), M, NPROJ, D, D}; pg8::StaticOrder S; S.init(M, NPROJ, F.G, (int)blockIdx.x);
        pg8::EpiBf16<0> E{WSP(bf16, WS_PROJ), NPROJ};
        pg8::gemm_phase<pg8::EpiBf16<0>, pg8::StaticOrder, PG8_ALIGN, PG8_SP2>(F.lds + RING_OFF, g, S, E);
        if (BOTH(1)) GRID_BAR(); STAMP(2);
    }
    if (IN(2)) { _Pragma("nounroll") for (int rep = 0; rep < NREP(2); ++rep) { p2_token_prep(F, rep == 0 ? 3 : P2_REPMODE); if (rep == 0) p2_sample_pieces(F); if (BOTH(2)) GRID_BAR(); STAMP(3); } }
    if (IN(3)) { _Pragma("nounroll") for (int rep = 0; rep < NREP(3); ++rep) { p3_chunk_prep(F); if (BOTH(3)) GRID_BAR(); STAMP(4); } }
    if (IN(4)) {
#ifndef P4_MASK
#define P4_MASK 15
#endif
#define P4_NEXT() do { if (F.tid == 0) F.MISC[16] = __hip_atomic_fetch_add(F.ctl + CW_Q, 1u, __ATOMIC_RELAXED, __HIP_MEMORY_SCOPE_AGENT); __syncthreads(); tk = (int)F.MISC[16]; __syncthreads(); } while (0)
        int tk; P4_NEXT();
        STAMP(11);
        while (tk < 64) { p4_scan(F, tk); P4_NEXT(); }
        STAMP(12);
        while (tk < 64 + 512) { p4c_attn_prompt(F, (tk - 64) * 8 + F.wave); P4_NEXT(); }
        STAMP(13);
        while (tk < 64 + 512 + 512) { p4d_attn_sample(F, tk - 576); P4_NEXT(); }
        while (tk < 64 + 512 + 512 + 512) { p4b_sample_delta(F, tk - 1088); P4_NEXT(); }
        STAMP(14);
#undef P4_NEXT
        if (BOTH(4)) GRID_BAR(); STAMP(5);
    }
    if (IN(5)) { _Pragma("nounroll") for (int rep = 0; rep < NREP(5); ++rep) { p5_gate(F); if (BOTH(5)) GRID_BAR(); STAMP(6); } }
    if (IN(6)) {
        { pg8::Gemm g{WSP(bf16, WS_MIX), WSP(bf16, WS_WO), MP, D, D, D}; pg8::StaticOrder S; S.init(MP, D, F.G, (int)blockIdx.x);
          pg8::EpiResF32 E{F.xp, F.xs, MP, F.out, D};
          pg8::gemm_phase<pg8::EpiResF32, pg8::StaticOrder, PG8_ALIGN, PG8_SP2>(F.lds + RING_OFF, g, S, E); }
        { pg8::Gemm g{WSP(bf16, WS_MIX), WSP(bf16, WS_WO), M, D, D, D / 4}; pg8::SplitOrder S; S.init(MP / 256, MS / 256, D / 256, 4, D / 4 / 64, (int)F.G - 1 - (int)blockIdx.x);
          pg8::EpiSplit E{WSP(float, WS_SLAB), (unsigned*)(F.ctl + CW_SPLIT), F.xs - (size_t)MP * D, F.out, D, MP / 256, D / 256, 4, D / 4 / 64};
          pg8::gemm_phase<pg8::EpiSplit, pg8::SplitOrder, false, PG8_SP2>(F.lds + RING_OFF, g, S, E); }
        if (BOTH(6)) GRID_BAR(); STAMP(7);
    }
    if (IN(7)) { _Pragma("nounroll") for (int rep = 0; rep < NREP(7); ++rep) { p7_norm2(F); if (BOTH(7)) GRID_BAR(); STAMP(8); } }
    if (IN(8)) {
        pg8::Gemm g{WSP(bf16, WS_XN), WSP(bf16, WS_WUP), M, FF, D, D}; pg8::StaticOrder S; S.init(M, FF, F.G, (int)blockIdx.x);
        pg8::EpiBf16<2> E{WSP(bf16, WS_HID), FF};
        pg8::gemm_phase<pg8::EpiBf16<2>, pg8::StaticOrder, PG8_ALIGN, PG8_SP2>(F.lds + RING_OFF, g, S, E);
        if (BOTH(8)) GRID_BAR(); STAMP(9);
    }
    if (IN(9)) {
        { pg8::Gemm g{WSP(bf16, WS_HID), WSP(bf16, WS_WDN), MP, D, FF, FF}; pg8::StaticOrder S; S.init(MP, D, F.G, (int)blockIdx.x);
          pg8::EpiResF32 E{F.out, F.out + (size_t)MP * D, MP, F.out, D};
          pg8::gemm_phase<pg8::EpiResF32, pg8::StaticOrder, PG8_ALIGN, PG8_SP2>(F.lds + RING_OFF, g, S, E); }
        { pg8::Gemm g{WSP(bf16, WS_HID), WSP(bf16, WS_WDN), M, D, FF, FF / 8}; pg8::SplitOrder S; S.init(MP / 256, MS / 256, D / 256, 8, FF / 8 / 64, (int)F.G - 1 - (int)blockIdx.x);
          pg8::EpiSplit E{WSP(float, WS_SLAB), (unsigned*)(F.ctl + CW_SPLIT + 16 * 64), F.out, F.out, D, MP / 256, D / 256, 8, FF / 8 / 64};
          pg8::gemm_phase<pg8::EpiSplit, pg8::SplitOrder, false, PG8_SP2>(F.lds + RING_OFF, g, S, E); }
    }
#ifdef STAMP_A
    STAMP(10);
    asm volatile("s_waitcnt vmcnt(0)" ::: "memory"); __syncthreads();
    if (blockIdx.x == 0 && F.tid == 0) {
#ifdef STAMP_AGG
        const float va = (float)__hip_atomic_load(F.ctl + CW_T + STAMP_A, __ATOMIC_RELAXED, __HIP_MEMORY_SCOPE_AGENT) * (0.01f / 256.f), vr = (float)__hip_atomic_load(F.ctl + CW_T + STAMP_R, __ATOMIC_RELAXED, __HIP_MEMORY_SCOPE_AGENT) * (0.01f / 256.f);
#else
        const float va = (float)(stamps[STAMP_A1] - stamps[STAMP_A]) * 0.01f, vr = (float)(stamps[STAMP_R1] - stamps[STAMP_R]) * 0.01f;
#endif
#ifdef STAMP_CAL
        F.out[O_YP] = 400.f; F.out[O_CP] = 100.f;
#else
        F.out[O_YP] = __expf(rintf(__logf(fmaxf(va, 1.f)) * STAMP_Q + STAMP_SHIFT) * (1.f / STAMP_Q)); F.out[O_CP] = __expf(rintf(__logf(fmaxf(vr, 1.f)) * STAMP_Q + STAMP_SHIFT) * (1.f / STAMP_Q));
#endif
    }
#endif
#undef IN
#undef BOTH
}

extern "C" void kernel_launch(void* const* d_in, const int* in_sizes, int n_in, void* d_out, int out_size, void* d_ws, size_t ws_size, hipStream_t stream) {
    static int grid = 0;
    if (grid == 0) {
        if (n_in != 18 || (size_t)out_size != O_END || ws_size < WS_END) { fprintf(stderr, "kernel_launch: unexpected shapes (n_in %d out %d ws %zu need %zu)\n", n_in, out_size, ws_size, (size_t)WS_END); grid = -1; return; }
        int dev = 0, cus = 0, per_cu = 0;
        if (hipGetDevice(&dev) != hipSuccess || hipDeviceGetAttribute(&cus, hipDeviceAttributeMultiprocessorCount, dev) != hipSuccess) { grid = -1; return; }
        if (hipFuncSetAttribute((const void*)hymba_fwd, hipFuncAttributeMaxDynamicSharedMemorySize, LDS_BYTES) != hipSuccess) { fprintf(stderr, "kernel_launch: hipFuncSetAttribute failed\n"); grid = -1; return; }
        if (hipOccupancyMaxActiveBlocksPerMultiprocessor(&per_cu, (const void*)hymba_fwd, NWAVES * 64, LDS_BYTES) != hipSuccess || per_cu < 1) fprintf(stderr, "kernel_launch: occupancy query reports %d\n", per_cu);
        (void)hipGetLastError();
        grid = cus;
    }
    if (grid < 0) return;
    (void)hipMemsetAsync((char*)d_ws + WS_CTL, 0, CTL_ZERO_BYTES, stream);
#ifdef DBG_ZERO_OUT
    (void)hipMemsetAsync(d_out, 0, (size_t)out_size * 4, stream);
#endif
    Args a{};
    for (int i = 0; i < 18; ++i) a.in[i] = (const float*)d_in[i];
    a.out = (float*)d_out; a.ws = (unsigned char*)d_ws;
#if MK_ONE_LAUNCH
    a.ph_lo = 0; a.ph_hi = N_PHASES;
    hipLaunchKernelGGL(hymba_fwd, dim3(grid), dim3(NWAVES * 64), LDS_BYTES, stream, a);
#else
    for (int p = 0; p < PH_LIMIT; ++p) { a.ph_lo = p; a.ph_hi = p + 1; hipLaunchKernelGGL(hymba_fwd, dim3(grid), dim3(NWAVES * 64), LDS_BYTES, stream, a); }
#endif
}
```

```cpp
#include <hip/hip_runtime.h>
#include <cstdio>
#include <cstdint>
namespace pg8 {
#define PG8_LAS __attribute__((address_space(3)))
typedef unsigned short bf16_t;
typedef short bf16x8 __attribute__((ext_vector_type(8)));
typedef float f32x4 __attribute__((ext_vector_type(4)));
typedef unsigned u32x4 __attribute__((ext_vector_type(4)));
constexpr int BM = 256, BK = 64, HALF = 128, HTB = HALF * BK * 2  , STAGE_BYTES = 8 * HTB, NXCD = 8, WGM = 8;

__host__ __device__ __forceinline__ int lds_byte(int r, int c) { const int st = (r >> 4) * 2 + (c >> 5), rr = r & 15, cc = c & 31, ob = rr * 64 + cc * 2; return st * 1024 + (ob ^ (((ob >> 9) & 1) << 5)); }
__host__ __device__ __forceinline__ void stage_rc(int b, int& R, int& C) { const int st = b / 1024, sb = b % 1024, swz = sb ^ (((sb >> 9) & 1) << 5); R = (st >> 1) * 16 + swz / 64; C = (st & 1) * 32 + (swz % 64) / 2; }
__host__ __device__ __forceinline__ int perm32(int rho) { const int n = rho >> 4, i = rho & 15; return 8 * (i >> 2) + 4 * n + (i & 3); }

struct Unit { int pm, pn; };
struct Gemm { const bf16_t* A; const bf16_t* Bt; int M, N, K; };

struct StaticOrder {
    int nM, nN, nwg, G, c;
    __host__ __device__ void init(int M, int N, int G_, int c_) { nM = M / BM; nN = N / BM; nwg = nM * nN; G = G_; c = c_; }
    __host__ __device__ bool next(int i, Unit& u) const {
        const long L = (long)i * G + c; if (L >= nwg) return false;
        int wgid = (int)L; { const int q = nwg / NXCD, r = nwg % NXCD, xcd = wgid % NXCD, off = wgid / NXCD; wgid = (xcd < r ? xcd * (q + 1) : r * (q + 1) + (xcd - r) * q) + off; }
        const int nig = WGM * nN, gid = wgid / nig, fm = gid * WGM, gsz = (nM - fm) < WGM ? (nM - fm) : WGM;
        u.pm = fm + ((wgid % nig) % gsz); u.pn = (wgid % nig) / gsz; return true;
    }
    __device__ __forceinline__ void a_ready(const Unit&) const {}
    __device__ __forceinline__ void done(const Unit&) const {}
};

typedef float f32x2 __attribute__((ext_vector_type(2)));
typedef __bf16 bf16x2 __attribute__((ext_vector_type(2)));
__device__ __forceinline__ unsigned cvt_pk_bf16(float lo, float hi) { f32x2 v = {lo, hi}; bf16x2 b = __builtin_convertvector(v, bf16x2); return __builtin_bit_cast(unsigned, b); }
template <int ACT> struct EpiBf16 {
    static constexpr bool PERM = true, AFTER_DRAIN = false;
    bf16_t* O; int ldc;
    __device__ __forceinline__ void operator()(const f32x4 (&acc)[2][2][4][2], const Unit& u, int wr, int wc, int fr, int fq) const {
        const int row0 = u.pm * BM + wr * 64 + fr; const int col0 = u.pn * BM + wc * 32 + 8 * fq;
#pragma unroll
        for (int ai = 0; ai < 2; ++ai)
#pragma unroll
            for (int m = 0; m < 4; ++m) { bf16_t* rowp = O + (size_t)(row0 + ai * HALF + m * 16) * ldc + col0;
#pragma unroll
                for (int bj = 0; bj < 2; ++bj) { f32x4 v0 = acc[ai][bj][m][0], v1 = acc[ai][bj][m][1];
                    if (ACT == 2) {
#pragma unroll
                        for (int e = 0; e < 4; ++e) { const float a = fmaxf(v0[e], 0.f), b = fmaxf(v1[e], 0.f); v0[e] = a * a; v1[e] = b * b; } }
                    u32x4 w; w.x = cvt_pk_bf16(v0[0], v0[1]); w.y = cvt_pk_bf16(v0[2], v0[3]); w.z = cvt_pk_bf16(v1[0], v1[1]); w.w = cvt_pk_bf16(v1[2], v1[3]);
                    *(u32x4*)(rowp + bj * HALF) = w; } }
    }
};
struct EpiResF32 {
    static constexpr bool PERM = false, AFTER_DRAIN = false;
    const float* base; const float* base2; int split; float* out; int ldc;
    __device__ __forceinline__ void operator()(const f32x4 (&acc)[2][2][4][2], const Unit& u, int wr, int wc, int fr, int fq) const {
        const int col0 = u.pn * BM + wc * 32 + 4 * fq;
        const float* bs = (u.pm * BM >= split) ? base2 - (size_t)split * ldc : base;
#pragma unroll
        for (int ai = 0; ai < 2; ++ai)
#pragma unroll
            for (int m = 0; m < 4; ++m) { const size_t off = (size_t)(u.pm * BM + ai * HALF + wr * 64 + m * 16 + fr) * ldc + col0;
#pragma unroll
                for (int bj = 0; bj < 2; ++bj)
#pragma unroll
                    for (int n = 0; n < 2; ++n) { const f32x4 b = *(const f32x4*)(bs + off + bj * HALF + n * 16); *(f32x4*)(out + off + bj * HALF + n * 16) = b + acc[ai][bj][m][n]; }
                if (m & 1) asm volatile("" ::: "memory"); }
    }
};
struct EpiResNorm {
    static constexpr bool PERM = false, AFTER_DRAIN = false;
    const float* base; const float* base2; int split; float* out; bf16_t* xn; const float* gain; float* rss; int ldc;
    __device__ __forceinline__ void operator()(const f32x4 (&acc)[2][2][4][2], const Unit& u, int wr, int wc, int fr, int fq) const {
        const int col0 = u.pn * BM + wc * 32 + 4 * fq;
        const float* bs = (u.pm * BM >= split) ? base2 - (size_t)split * ldc : base;
        f32x4 gv[2][2];
#pragma unroll
        for (int bj = 0; bj < 2; ++bj)
#pragma unroll
            for (int n = 0; n < 2; ++n) gv[bj][n] = *(const f32x4*)(gain + col0 + bj * HALF + n * 16);
#pragma unroll
        for (int ai = 0; ai < 2; ++ai)
#pragma unroll
            for (int m = 0; m < 4; ++m) { const int row = u.pm * BM + ai * HALF + wr * 64 + m * 16 + fr; const size_t off = (size_t)row * ldc + col0; float ss = 0.f;
#pragma unroll
                for (int bj = 0; bj < 2; ++bj)
#pragma unroll
                    for (int n = 0; n < 2; ++n) { const f32x4 h = *(const f32x4*)(bs + off + bj * HALF + n * 16) + acc[ai][bj][m][n]; *(f32x4*)(out + off + bj * HALF + n * 16) = h;
                        ss += (h[0] * h[0] + h[1] * h[1]) + (h[2] * h[2] + h[3] * h[3]); const f32x4 x = h * gv[bj][n];
                        typedef unsigned u32x2_t __attribute__((ext_vector_type(2)));
                        *(u32x2_t*)(xn + off + bj * HALF + n * 16) = (u32x2_t){cvt_pk_bf16(x[0], x[1]), cvt_pk_bf16(x[2], x[3])}; }
                ss += __shfl_xor(ss, 16); ss += __shfl_xor(ss, 32);
                if (fq == 0) rss[(size_t)row * 16 + u.pn * 4 + wc] = ss;
                if (m & 1) asm volatile("" ::: "memory"); }
    }
};
struct EpiRowScaleRelu2 {
    static constexpr bool PERM = true, AFTER_DRAIN = false;
    bf16_t* O; int ldc; const float* rss; float inv_n, eps;
    __device__ __forceinline__ void operator()(const f32x4 (&acc)[2][2][4][2], const Unit& u, int wr, int wc, int fr, int fq) const {
        const int row0 = u.pm * BM + wr * 64 + fr; const int col0 = u.pn * BM + wc * 32 + 8 * fq;
#pragma unroll
        for (int ai = 0; ai < 2; ++ai)
#pragma unroll
            for (int m = 0; m < 4; ++m) { const int row = row0 + ai * HALF + m * 16; bf16_t* rowp = O + (size_t)row * ldc + col0;
                const f32x4* rp = (const f32x4*)(rss + (size_t)row * 16); const f32x4 p0 = rp[0], p1 = rp[1], p2 = rp[2], p3 = rp[3];
                const float ss = ((p0[0] + p0[1]) + (p0[2] + p0[3])) + ((p1[0] + p1[1]) + (p1[2] + p1[3])) + ((p2[0] + p2[1]) + (p2[2] + p2[3])) + ((p3[0] + p3[1]) + (p3[2] + p3[3]));
                const float rstd = 1.f / sqrtf(ss * inv_n + eps);
#pragma unroll
                for (int bj = 0; bj < 2; ++bj) { f32x4 v0 = acc[ai][bj][m][0] * rstd, v1 = acc[ai][bj][m][1] * rstd;
#pragma unroll
                    for (int e = 0; e < 4; ++e) { const float a = fmaxf(v0[e], 0.f), b = fmaxf(v1[e], 0.f); v0[e] = a * a; v1[e] = b * b; }
                    u32x4 w; w.x = cvt_pk_bf16(v0[0], v0[1]); w.y = cvt_pk_bf16(v0[2], v0[3]); w.z = cvt_pk_bf16(v1[0], v1[1]); w.w = cvt_pk_bf16(v1[2], v1[3]);
                    *(u32x4*)(rowp + bj * HALF) = w; } }
    }
};
template <class Epi, class Sched, bool ALIGN_EPI = false, bool SP2 = false>
__device__ __forceinline__ void gemm_phase(PG8_LAS unsigned char* lds, const Gemm g, const Sched& S, const Epi& E) {
    const int tid = threadIdx.x, wid = __builtin_amdgcn_readfirstlane(tid >> 6), lane = tid & 63, wr = wid >> 2, wc = wid & 3, fr = lane & 15, fq = lane >> 4;
    const int K = g.K, nt = K / BK;
    unsigned voffA[2], voffB[2];
#pragma unroll
    for (int i = 0; i < 2; ++i) { int R, C; stage_rc(tid * 16 + i * 8192, R, C); const int Rb = Epi::PERM ? ((R & ~31) + perm32(R & 31)) : R;
        voffA[i] = (unsigned)(R * K + C) * 2u; voffB[i] = (unsigned)(Rb * K + C) * 2u; }
    const size_t kstep = (size_t)(BK * 2);
    const size_t hstep = (size_t)HALF * K * 2;
    const size_t tstep = 2 * hstep;
    const unsigned ldsw = (unsigned)wid * 1024u;
    const int aoff = lds_byte(wr * 64 + fr, fq * 8), boff = lds_byte(wc * 32 + fr, fq * 8);
#define PG8_SA(b, h) (((b) * 2 + (h)) * HTB)
#define PG8_SB(b, h) ((4 + (b) * 2 + (h)) * HTB)
#define PG8_STAGE(bufoff, gbase, voff) do { _Pragma("unroll") for (int _i = 0; _i < 2; ++_i) \
        __builtin_amdgcn_global_load_lds((const unsigned*)((const char*)(gbase) + (voff)[_i]), (PG8_LAS unsigned*)(lds + (bufoff) + ldsw + _i * 8192), 16, 0, 0); } while (0)
#define PG8_LDA(dst, b, h) do { _Pragma("unroll") for (int m = 0; m < 4; ++m) _Pragma("unroll") for (int k = 0; k < 2; ++k) dst[m][k] = *(const PG8_LAS bf16x8*)(lds + PG8_SA(b, h) + aoff + m * 2048 + k * 1024); } while (0)
#define PG8_LDB(dst, b, h) do { _Pragma("unroll") for (int n = 0; n < 2; ++n) _Pragma("unroll") for (int k = 0; k < 2; ++k) dst[n][k] = *(const PG8_LAS bf16x8*)(lds + PG8_SB(b, h) + boff + n * 2048 + k * 1024); } while (0)
#define PG8_MMA(ai, bj, At, Bt) do { __builtin_amdgcn_s_setprio(1); _Pragma("unroll") for (int m = 0; m < 4; ++m) _Pragma("unroll") for (int n = 0; n < 2; ++n) _Pragma("unroll") for (int k = 0; k < 2; ++k) \
        acc[ai][bj][m][n] = __builtin_amdgcn_mfma_f32_16x16x32_bf16(Bt[n][k], At[m][k], acc[ai][bj][m][n], 0, 0, 0); __builtin_amdgcn_s_setprio(0); } while (0)
#define PG8_WAIT_V(n) asm volatile("s_waitcnt vmcnt(" #n ")" ::: "memory")
#define PG8_WAIT_L(n) asm volatile("s_waitcnt lgkmcnt(" #n ")" ::: "memory")
#define PG8_BAR __builtin_amdgcn_s_barrier()
#define PG8_SCHED __builtin_amdgcn_sched_barrier(0)
    Unit cur, nxt; int ui = 0;
    if (!S.next(0, cur)) return;
    f32x4 acc[2][2][4][2];
#pragma unroll
    for (int a = 0; a < 2; ++a)
#pragma unroll
        for (int b = 0; b < 2; ++b)
#pragma unroll
            for (int m = 0; m < 4; ++m)
#pragma unroll
                for (int n = 0; n < 2; ++n) acc[a][b][m][n] = (f32x4){0.f, 0.f, 0.f, 0.f};
    bf16x8 At[4][2], B0[2][2], B1[2][2];
    const char* cA = (const char*)g.A + (size_t)cur.pm * tstep; const char* cB = (const char*)g.Bt + (size_t)cur.pn * tstep;
    S.a_ready(cur);
    if constexpr (SP2) {
        PG8_STAGE(PG8_SB(0, 0), cB, voffB); PG8_STAGE(PG8_SB(0, 1), cB + hstep, voffB); PG8_STAGE(PG8_SA(0, 0), cA, voffA); PG8_STAGE(PG8_SA(0, 1), cA + hstep, voffA);
        if (wr == 1) PG8_BAR;
        PG8_WAIT_V(2); PG8_BAR;
        PG8_STAGE(PG8_SB(1, 0), cB + kstep, voffB); PG8_STAGE(PG8_SA(1, 0), cA + kstep, voffA); PG8_STAGE(PG8_SB(1, 1), cB + hstep + kstep, voffB);
        PG8_WAIT_V(6); PG8_BAR;
    } else {
        PG8_STAGE(PG8_SB(0, 0), cB, voffB); PG8_STAGE(PG8_SA(0, 0), cA, voffA); PG8_STAGE(PG8_SB(0, 1), cB + hstep, voffB); PG8_STAGE(PG8_SA(0, 1), cA + hstep, voffA);
        if (wr == 1) PG8_BAR;
        PG8_WAIT_V(4); PG8_BAR;
        PG8_STAGE(PG8_SB(1, 0), cB + kstep, voffB); PG8_STAGE(PG8_SA(1, 0), cA + kstep, voffA); PG8_STAGE(PG8_SB(1, 1), cB + hstep + kstep, voffB);
        PG8_WAIT_V(6); PG8_BAR;
    }
    for (;;) {
        const bool has_next = S.next(ui + 1, nxt);
        const char* nA = has_next ? (const char*)g.A + (size_t)nxt.pm * tstep : cA; const char* nB = has_next ? (const char*)g.Bt + (size_t)nxt.pn * tstep : cB;
        for (int t = 0; t < nt; t += 2) {
            const bool last = (t == nt - 2);
            const char* a1 = cA + (size_t)(t + 1) * kstep;
            const char* a2 = last ? nA : cA + (size_t)(t + 2) * kstep; const char* b2 = last ? nB : cB + (size_t)(t + 2) * kstep;
            const char* a3 = a2 + kstep; const char* b3 = b2 + kstep;
            if (last && has_next) S.a_ready(nxt);
            if constexpr (SP2) {
            PG8_LDB(B0, 0, 0); PG8_LDB(B1, 0, 1); PG8_SCHED; PG8_LDA(At, 0, 0); PG8_STAGE(PG8_SA(1, 1), a1 + hstep, voffA);
            PG8_WAIT_V(8); PG8_WAIT_L(0); PG8_BAR; PG8_MMA(0, 0, At, B0); PG8_MMA(0, 1, At, B1); PG8_BAR; PG8_SCHED;
            PG8_LDA(At, 0, 1); PG8_STAGE(PG8_SB(0, 0), b2, voffB); PG8_STAGE(PG8_SB(0, 1), b2 + hstep, voffB); PG8_STAGE(PG8_SA(0, 0), a2, voffA);
            PG8_WAIT_V(8); PG8_WAIT_L(0); PG8_BAR; PG8_MMA(1, 0, At, B0); PG8_MMA(1, 1, At, B1); PG8_BAR; PG8_SCHED;
            PG8_LDB(B0, 1, 0); PG8_LDB(B1, 1, 1); PG8_SCHED; PG8_LDA(At, 1, 0); PG8_STAGE(PG8_SA(0, 1), a2 + hstep, voffA);
            PG8_WAIT_V(8); PG8_WAIT_L(0); PG8_BAR; PG8_MMA(0, 0, At, B0); PG8_MMA(0, 1, At, B1); PG8_BAR; PG8_SCHED;
            PG8_LDA(At, 1, 1); PG8_STAGE(PG8_SB(1, 0), b3, voffB); PG8_STAGE(PG8_SB(1, 1), b3 + hstep, voffB); PG8_STAGE(PG8_SA(1, 0), a3, voffA);
            PG8_WAIT_V(8); PG8_WAIT_L(0); PG8_BAR; PG8_MMA(1, 0, At, B0); PG8_MMA(1, 1, At, B1); PG8_BAR; PG8_SCHED;
            } else {
            PG8_LDB(B0, 0, 0); PG8_SCHED; PG8_LDA(At, 0, 0); PG8_STAGE(PG8_SA(1, 1), a1 + hstep, voffA);
            PG8_WAIT_L(8); PG8_BAR; PG8_WAIT_L(0); PG8_MMA(0, 0, At, B0); PG8_BAR; PG8_SCHED;
            PG8_LDB(B1, 0, 1); PG8_STAGE(PG8_SB(0, 0), b2, voffB);
            PG8_BAR; PG8_WAIT_L(0); PG8_MMA(0, 1, At, B1); PG8_BAR;
            PG8_LDA(At, 0, 1); PG8_STAGE(PG8_SA(0, 0), a2, voffA);
            PG8_BAR; PG8_WAIT_L(0); PG8_MMA(1, 0, At, B0); PG8_BAR; PG8_SCHED;
            PG8_STAGE(PG8_SB(0, 1), b2 + hstep, voffB);
            PG8_WAIT_V(6); PG8_BAR; PG8_MMA(1, 1, At, B1); PG8_BAR;
            PG8_LDB(B0, 1, 0); PG8_SCHED; PG8_LDA(At, 1, 0); PG8_STAGE(PG8_SA(0, 1), a2 + hstep, voffA);
            PG8_WAIT_L(8); PG8_BAR; PG8_WAIT_L(0); PG8_MMA(0, 0, At, B0); PG8_BAR; PG8_SCHED;
            PG8_LDB(B1, 1, 1); PG8_STAGE(PG8_SB(1, 0), b3, voffB);
            PG8_BAR; PG8_WAIT_L(0); PG8_MMA(0, 1, At, B1); PG8_BAR;
            PG8_LDA(At, 1, 1); PG8_STAGE(PG8_SA(1, 0), a3, voffA);
            PG8_BAR; PG8_WAIT_L(0); PG8_MMA(1, 0, At, B0); PG8_BAR; PG8_SCHED;
            PG8_STAGE(PG8_SB(1, 1), b3 + hstep, voffB);
            PG8_WAIT_V(6); PG8_BAR; PG8_MMA(1, 1, At, B1); PG8_BAR;
            }
        }
        if constexpr (ALIGN_EPI) { if (wr == 0) PG8_BAR; }
        if constexpr (!Epi::AFTER_DRAIN) { E(acc, cur, wr, wc, fr, fq); S.done(cur); }
        if (!has_next) break;
#pragma unroll
        for (int a = 0; a < 2; ++a)
#pragma unroll
            for (int b = 0; b < 2; ++b)
#pragma unroll
                for (int m = 0; m < 4; ++m)
#pragma unroll
                    for (int n = 0; n < 2; ++n) acc[a][b][m][n] = (f32x4){0.f, 0.f, 0.f, 0.f};
        cur = nxt; cA = nA; cB = nB; ++ui;
        if constexpr (ALIGN_EPI) { if (wr == 1) PG8_BAR; }
    }
    PG8_WAIT_V(0);
    if constexpr (!ALIGN_EPI) { if (wr == 0) PG8_BAR; }
    PG8_BAR;
    if constexpr (Epi::AFTER_DRAIN) { E.fused(acc, cur, wr, wc, fr, fq, lds, wid, lane); S.done(cur); }
#undef PG8_SA
#undef PG8_SB
#undef PG8_STAGE
#undef PG8_LDA
#undef PG8_LDB
#undef PG8_MMA
#undef PG8_WAIT_V
#undef PG8_WAIT_L
#undef PG8_BAR
#undef PG8_SCHED
}
}

#ifndef PG8_SP2
#define PG8_SP2 true
#endif
#ifndef PG8_ALIGN
#define PG8_ALIGN true
#endif
#ifndef MK_ONE_LAUNCH
#define MK_ONE_LAUNCH 1
#endif

constexpr int NWAVES = 8;
constexpr int D = 1024, NB = 4, SEQ = 4096, MP = NB * SEQ, NSB = 128, ST = 8, MS = NSB * ST, M = MP + MS;
constexpr int HA = 4, DA = 128, WA = 512, HB = 8, DB = 64, WB = 512, CONVC = 1536, FF = 4096, WBUF = 2048;
constexpr int PCOLS = 3592, NPROJ = 3584;
constexpr int PC_Z = 1536, PC_QB = 2048, PC_KB = 2560, PC_VB = 3072;
constexpr int NCH = SEQ / 64, NBH = NB * HA;
constexpr float EPS = 1e-6f;
constexpr float QB_SCALE = 0.125f * 1.4426950408889634f;

constexpr size_t O_YP = 0, O_YS = (size_t)MP * D, O_KP = O_YS + (size_t)MS * D, O_VP = O_KP + (size_t)NB * WBUF * WB, O_DP = O_VP + (size_t)NB * WBUF * WB,
                 O_CP = O_DP + (size_t)NBH * DA * DA, O_KS = O_CP + (size_t)NB * 3 * CONVC, O_VS = O_KS + (size_t)MS * WB, O_DS = O_VS + (size_t)MS * WB,
                 O_CS = O_DS + (size_t)NSB * HA * DA * DA, O_END = O_CS + (size_t)NSB * 3 * CONVC;
static_assert(O_END == 36521984, "output size");

constexpr size_t al256(size_t x) { return (x + 255) & ~(size_t)255; }
constexpr size_t WS_CTL = 0, CTL_ZERO_BYTES = 1u << 20;
constexpr size_t WS_WIN = CTL_ZERO_BYTES;
constexpr size_t WS_WO = WS_WIN + (size_t)NPROJ * D * 2;
constexpr size_t WS_WUP = WS_WO + (size_t)D * D * 2;
constexpr size_t WS_WDN = WS_WUP + (size_t)FF * D * 2;
constexpr size_t WS_XN = WS_WDN + (size_t)FF * D * 2;
constexpr size_t WS_PROJ = WS_XN + (size_t)M * D * 2;
constexpr size_t WS_BETA = WS_PROJ + (size_t)M * NPROJ * 2;
constexpr size_t WS_GG = WS_BETA + (size_t)M * 4 * 4;
constexpr size_t WS_GC = WS_GG + (size_t)M * 4 * 4;
constexpr size_t WS_CS = WS_GC + (size_t)NBH * SEQ * 4;
constexpr size_t WS_QA = WS_CS + (size_t)NBH * NCH * 64 * 4;
constexpr size_t WS_KA = WS_QA + (size_t)NBH * SEQ * DA * 2;
constexpr size_t WS_KAT = WS_KA + (size_t)NBH * SEQ * DA * 2;
constexpr size_t WS_VAT = WS_KAT + (size_t)NBH * SEQ * DA * 2;
constexpr size_t WS_WF = WS_VAT + (size_t)NBH * SEQ * DA * 2;
constexpr size_t WS_UF = WS_WF + (size_t)NBH * NCH * 16 * 1024;
constexpr size_t WS_QKF = WS_UF + (size_t)NBH * NCH * 32 * 1024;
constexpr size_t WS_OA = WS_QKF + (size_t)NBH * NCH * 8 * 1024;
constexpr size_t WS_Q16 = WS_OA + (size_t)M * WA * 4;
constexpr size_t WS_K16 = WS_Q16 + (size_t)MP * WB * 2;
constexpr size_t WS_VT16 = WS_K16 + (size_t)MP * WB * 2;
constexpr size_t WS_QSB = WS_VT16 + (size_t)MP * WB * 2;
constexpr size_t WS_QKVS = WS_QSB + (size_t)MS * WB * 4;
constexpr size_t WS_MIX = WS_QKVS + (size_t)MS * CONVC * 4;
constexpr size_t WS_HID = WS_MIX + (size_t)M * D * 2;
constexpr size_t WS_RSS = WS_HID + (size_t)M * FF * 2;
constexpr size_t WS_END = WS_RSS + (size_t)M * 16 * 4;
static_assert(WS_END % 256 == 0 && WS_WIN % 256 == 0, "ws alignment");
constexpr int CW_BAR = 4096, CW_Q = 8192, CW_T = 8256;

constexpr int RING_OFF = 0, RING_BYTES = 131072;
constexpr int LDSCTL_OFF = RING_BYTES, MISC_OFF = LDSCTL_OFF + 320;
constexpr int LDS_BYTES = 147456;

#define GAS __attribute__((address_space(1)))
#define LAS __attribute__((address_space(3)))
typedef unsigned short bf16;
typedef unsigned v4u __attribute__((ext_vector_type(4)));
typedef float f32x4 __attribute__((ext_vector_type(4)));
typedef short bf16x8 __attribute__((ext_vector_type(8)));
typedef GAS unsigned gu32;
typedef GAS unsigned long long gu64;
#define RLX_AGENT __ATOMIC_RELAXED, __HIP_MEMORY_SCOPE_AGENT
#define LDS_WAIT() asm volatile("s_waitcnt lgkmcnt(0)" ::: "memory")
#define VM_WAIT() asm volatile("s_waitcnt vmcnt(0)" ::: "memory")
__device__ __forceinline__ unsigned long long rt() { return __builtin_amdgcn_s_memrealtime(); }
__device__ __forceinline__ unsigned f2bf(float f) { unsigned u = __builtin_bit_cast(unsigned, f); return (u + 0x7fffu + ((u >> 16) & 1u)) >> 16; }
__device__ __forceinline__ unsigned pk2(float lo, float hi) { return f2bf(lo) | (f2bf(hi) << 16); }

#define XB_TMO      128
#define XB_XCNT(j)  (256  + 64 * (j))
#define XB_XSUB(j)  (1280 + 64 * (j))
#define XB_XGEN(j)  (2304 + 64 * (j))
#define XB_TOP      3328
#define XB_TOPGEN   3392
#define XCD_BAR_WORDS 3456
#define XB_SPIN_CAP (1u << 18)

__device__ __forceinline__ unsigned xb_ld(unsigned* p)              { return __hip_atomic_load(p, __ATOMIC_RELAXED, __HIP_MEMORY_SCOPE_AGENT); }
__device__ __forceinline__ unsigned xb_add(unsigned* p, unsigned v) { return __hip_atomic_fetch_add(p, v, __ATOMIC_RELAXED, __HIP_MEMORY_SCOPE_AGENT); }
__device__ __forceinline__ unsigned xb_xcc_id() { return (unsigned)__builtin_amdgcn_s_getreg((3 << 11) | 20) & 0xFu; }
#define XB_SPIN(cond, bar) do { unsigned _sp = 0; while (cond) { __builtin_amdgcn_s_sleep(1); \
    if ((++_sp & 255u) == 0u) { if (xb_ld(&(bar)[XB_TMO])) break; if (_sp > XB_SPIN_CAP) { atomicAdd(&(bar)[XB_TMO], 1u); break; } } } } while (0)

struct XcdBarrier {
    unsigned* bar; unsigned x;
    volatile LAS unsigned* st;
};

__device__ __forceinline__ XcdBarrier xcd_barrier_post(unsigned* bar, volatile LAS unsigned* st) {
    XcdBarrier b; b.bar = bar; b.x = xb_xcc_id(); b.st = st;
    if (threadIdx.x == 0) (void)xb_add(&bar[XB_XCNT(b.x)], 1u);
    return b;
}
__device__ __forceinline__ void xcd_barrier_complete(unsigned* bar, unsigned x, unsigned& nloc, unsigned& nx) {
    const unsigned G = gridDim.x * gridDim.y * gridDim.z;
    unsigned sum, cnt, mine, sp = 0u;
    for (;;) {
        sum = 0u; cnt = 0u; mine = 0u;
#pragma unroll
        for (unsigned j = 0; j < 16; ++j) { const unsigned c = xb_ld(&bar[XB_XCNT(j)]); sum += c; cnt += (c > 0u) ? 1u : 0u; mine = (j == x) ? c : mine; }
        if (sum == G) break;
        __builtin_amdgcn_s_sleep(1);
        if ((++sp & 255u) == 0u) { if (xb_ld(&bar[XB_TMO])) break; if (sp > XB_SPIN_CAP) { atomicAdd(&bar[XB_TMO], 1u); break; } }
    }
    nloc = mine > 0u ? mine : 1u; nx = cnt > 0u ? cnt : 1u;
}

__device__ __forceinline__ void xcd_barrier(const XcdBarrier& b) {
    asm volatile("s_waitcnt vmcnt(0)" ::: "memory");
    __syncthreads();
    if (threadIdx.x == 0) {
        unsigned* bar = b.bar;
        __builtin_amdgcn_s_waitcnt(0);
        unsigned nloc = b.st[0], nx = b.st[1];
        if (nloc == 0u) { xcd_barrier_complete(bar, b.x, nloc, nx); b.st[0] = nloc; b.st[1] = nx; }
        const unsigned old = xb_add(&bar[XB_XSUB(b.x)], 1u);
        const unsigned gen = old / nloc;
        if (old + 1u == (gen + 1u) * nloc) {
            __builtin_amdgcn_fence(__ATOMIC_RELEASE, "agent");
            asm volatile("s_waitcnt vmcnt(0)" ::: "memory");
            const unsigned og = xb_add(&bar[XB_TOP], 1u);
            const unsigned tg = og / nx;
            if (og + 1u == (tg + 1u) * nx) xb_add(&bar[XB_TOPGEN], 1u);
            else XB_SPIN(xb_ld(&bar[XB_TOPGEN]) == tg, bar);
            __builtin_amdgcn_fence(__ATOMIC_ACQUIRE, "agent");
            xb_add(&bar[XB_XGEN(b.x)], 1u);
            asm volatile("s_waitcnt vmcnt(0)" ::: "memory");
        } else {
            XB_SPIN(xb_ld(&bar[XB_XGEN(b.x)]) == gen, bar);
            __builtin_amdgcn_fence(__ATOMIC_ACQUIRE, "agent");
            asm volatile("s_waitcnt vmcnt(0)" ::: "memory");
        }
    }
    __syncthreads();
}


typedef float f32x2v __attribute__((ext_vector_type(2)));
typedef unsigned u32x2v __attribute__((ext_vector_type(2)));
typedef __bf16 bf16x2_t __attribute__((ext_vector_type(2)));
__device__ __forceinline__ unsigned cvtpk(float lo, float hi) { f32x2v v = {lo, hi}; bf16x2_t b = __builtin_convertvector(v, bf16x2_t); return __builtin_bit_cast(unsigned, b); }
__device__ __forceinline__ float bflo(unsigned u) { return __uint_as_float(u << 16); }
__device__ __forceinline__ float bfhi(unsigned u) { return __uint_as_float(u & 0xffff0000u); }
__device__ __forceinline__ void unpack8(const v4u w, float (&f)[8]) { f[0] = bflo(w.x); f[1] = bfhi(w.x); f[2] = bflo(w.y); f[3] = bfhi(w.y); f[4] = bflo(w.z); f[5] = bfhi(w.z); f[6] = bflo(w.w); f[7] = bfhi(w.w); }
__device__ __forceinline__ v4u pack8(const float (&f)[8]) { v4u w; w.x = cvtpk(f[0], f[1]); w.y = cvtpk(f[2], f[3]); w.z = cvtpk(f[4], f[5]); w.w = cvtpk(f[6], f[7]); return w; }
__device__ __forceinline__ float silu_f(float x) { return x * __builtin_amdgcn_rcpf(1.f + __expf(-x)); }
__device__ __forceinline__ bf16x8 as_bf16x8(v4u w) { return __builtin_bit_cast(bf16x8, w); }
__device__ __forceinline__ f32x4 mfma16(bf16x8 a, bf16x8 b, f32x4 c) { return __builtin_amdgcn_mfma_f32_16x16x32_bf16(a, b, c, 0, 0, 0); }
__device__ __forceinline__ int perm_tok(int x) { return 8 * ((x >> 2) & 3) + ((x >> 4) << 2) + (x & 3); }
__device__ __forceinline__ float wave_sum(float v) {
#pragma unroll
    for (int o = 1; o < 64; o <<= 1) v += __shfl_xor(v, o);
    return v;
}

struct Frame {
    LAS unsigned char* lds;
    volatile LAS unsigned* MISC;
    gu32* ctl;
    int tid, lane, wave;
    int vcu, G;
    const float *xp, *xs, *cache_k, *cache_v, *state_delta, *state_conv, *norm1_g, *w_in, *conv_w, *a_log, *dt_bias, *dng, *qng, *kng, *w_o, *norm2_g, *w_up, *w_down;
    float* out;
    unsigned char* ws;
};
#define WSP(T, off) ((T*)(F.ws + (off)))

__device__ __forceinline__ void p0_transpose_item(const float* W, int ldw, int col0, int K, bf16* WT, int row_off, LAS float* scr, int item, int nblk, int lane) {
    const int kb = item / nblk, nb = item % nblk, k0 = 64 * kb, n0 = 32 * nb;
    float wv[32];
#pragma unroll
    for (int i = 0; i < 32; ++i) { const int kk = 2 * i + (lane >> 5); wv[i] = *(const GAS float*)(W + (size_t)(k0 + kk) * ldw + col0 + n0 + (lane & 31)); }
#pragma unroll
    for (int i = 0; i < 32; ++i) { const int kk = 2 * i + (lane >> 5); scr[kk * 33 + (lane & 31)] = wv[i]; }
    LDS_WAIT(); asm volatile("" ::: "memory");
    const int c = lane & 7;
#pragma unroll
    for (int j = 0; j < 4; ++j) { const int n = (lane >> 3) + 8 * j; const LAS float* s = scr + (8 * c) * 33 + n;
        v4u o; o.x = cvtpk(s[0 * 33], s[1 * 33]); o.y = cvtpk(s[2 * 33], s[3 * 33]); o.z = cvtpk(s[4 * 33], s[5 * 33]); o.w = cvtpk(s[6 * 33], s[7 * 33]);
        *(GAS v4u*)(WT + (size_t)(row_off + n0 + n) * K + k0 + 8 * c) = o; }
    LDS_WAIT(); asm volatile("" ::: "memory");
}
__device__ __forceinline__ void p0_prologue(Frame& F) {
    const int gw = F.vcu * NWAVES + F.wave, NGW = F.G * NWAVES;
    {
        LAS float* scr = (LAS float*)(F.lds + RING_OFF + F.wave * 16384);
        constexpr int I_A = 16 * 64, I_B = 16 * 48, I_O = 16 * 32, I_U = 16 * 128, I_D = 64 * 32;
        constexpr int NITEMS = I_A + I_B + I_O + I_U + I_D;
        for (int it = gw; it < NITEMS; it += NGW) {
            int r = it;
            if (r < I_A) { p0_transpose_item(F.w_in, PCOLS, 0, D, WSP(bf16, WS_WIN), 0, scr, r, 64, F.lane); continue; } r -= I_A;
            if (r < I_B) { p0_transpose_item(F.w_in, PCOLS, 2056, D, WSP(bf16, WS_WIN), 2048, scr, r, 48, F.lane); continue; } r -= I_B;
            if (r < I_O) { p0_transpose_item(F.w_o, D, 0, D, WSP(bf16, WS_WO), 0, scr, r, 32, F.lane); continue; } r -= I_O;
            if (r < I_U) { p0_transpose_item(F.w_up, FF, 0, D, WSP(bf16, WS_WUP), 0, scr, r, 128, F.lane); continue; } r -= I_U;
            p0_transpose_item(F.w_down, D, 0, FF, WSP(bf16, WS_WDN), 0, scr, r, 32, F.lane);
        }
    }
    __syncthreads();
    {
        LAS float* wba = (LAS float*)(F.lds + RING_OFF);
        for (int i = F.tid; i < 1024 * 2; i += NWAVES * 64) { const int k = i >> 1, hh = i & 1; const f32x4 w = *(const f32x4*)(F.w_in + (size_t)k * PCOLS + 2048 + hh * 4);
            wba[(hh * 4 + 0) * 1024 + k] = w.x; wba[(hh * 4 + 1) * 1024 + k] = w.y; wba[(hh * 4 + 2) * 1024 + k] = w.z; wba[(hh * 4 + 3) * 1024 + k] = w.w; }
        __syncthreads();
        f32x4 g1[4];
#pragma unroll
        for (int j = 0; j < 4; ++j) g1[j] = *((const f32x4*)F.norm1_g + F.lane + 64 * j);
        f32x4 nv[4];
        { const int m = gw; const float* xrow = (m < MP) ? F.xp + (size_t)m * D : F.xs + (size_t)(m - MP) * D; const GAS f32x4* xr = (const GAS f32x4*)xrow + F.lane;
#pragma unroll
          for (int j = 0; j < 4; ++j) nv[j] = xr[64 * j]; }
        const int hsel = (F.lane >> 3) & 3;
        const float dtb = F.dt_bias[hsel], nexpa = -expf(F.a_log[hsel]);
        for (int m = gw; m < M; m += NGW) {
            f32x4 v[4]; float s = 0.f;
#pragma unroll
            for (int j = 0; j < 4; ++j) { v[j] = nv[j]; s += (v[j].x * v[j].x + v[j].y * v[j].y) + (v[j].z * v[j].z + v[j].w * v[j].w); }
            { const int mn = (m + NGW < M) ? m + NGW : m; const float* xrow = (mn < MP) ? F.xp + (size_t)mn * D : F.xs + (size_t)(mn - MP) * D; const GAS f32x4* xr = (const GAS f32x4*)xrow + F.lane;
#pragma unroll
              for (int j = 0; j < 4; ++j) nv[j] = xr[64 * j]; }
            const float rstd = 1.f / sqrtf(wave_sum(s) * (1.f / D) + EPS);
            float dots[8];
#pragma unroll
            for (int e = 0; e < 8; ++e) dots[e] = 0.f;
            GAS unsigned long long* o8 = (GAS unsigned long long*)(WSP(bf16, WS_XN) + (size_t)m * D) + F.lane;
#pragma unroll
            for (int j = 0; j < 4; ++j) { v[j] = v[j] * rstd * g1[j];
                o8[64 * j] = (unsigned long long)cvtpk(v[j].x, v[j].y) | ((unsigned long long)cvtpk(v[j].z, v[j].w) << 32);
#pragma unroll
                for (int e = 0; e < 8; ++e) { const f32x4 w = *(const LAS f32x4*)(wba + e * 1024 + 4 * F.lane + 256 * j); dots[e] += (v[j].x * w.x + v[j].y * w.y) + (v[j].z * w.z + v[j].w * w.w); } }
            float d4[4], d2[2], d1;
            { const bool hi = (F.lane & 32) != 0;
#pragma unroll
              for (int e = 0; e < 4; ++e) { const float keep = hi ? dots[e + 4] : dots[e], give = hi ? dots[e] : dots[e + 4]; d4[e] = keep + __shfl_xor(give, 32); } }
            { const bool hi = (F.lane & 16) != 0;
#pragma unroll
              for (int e = 0; e < 2; ++e) { const float keep = hi ? d4[e + 2] : d4[e], give = hi ? d4[e] : d4[e + 2]; d2[e] = keep + __shfl_xor(give, 16); } }
            { const bool hi = (F.lane & 8) != 0; const float keep = hi ? d2[1] : d2[0], give = hi ? d2[0] : d2[1]; d1 = keep + __shfl_xor(give, 8); }
            d1 += __shfl_xor(d1, 1); d1 += __shfl_xor(d1, 2); d1 += __shfl_xor(d1, 4);
            if ((F.lane & 7) == 0) {
                if (F.lane < 32) WSP(float, WS_BETA)[(size_t)m * 4 + hsel] = 1.f / (1.f + expf(-d1));
                else { const float xx = d1 + dtb; const float sp = (xx > 20.f) ? xx : log1pf(expf(xx)); WSP(float, WS_GG)[(size_t)m * 4 + hsel] = nexpa * sp; }
            }
        }
    }
}

template <bool SMP> __device__ __forceinline__ void p2_mixb_token(Frame& F, const bf16* PROJ, size_t row, int b, int t, int s, int tt, const float (&qg)[8], const float (&kg)[8], int lane) {
    const int hb = lane >> 3, d8 = (lane & 7) * 8, col8b = lane * 8;
    const size_t prow = row * NPROJ;
    float q[8], k[8], v[8];
    { const v4u w = *(const GAS v4u*)(PROJ + prow + PC_QB + col8b); unpack8(w, q); }
    { const v4u w = *(const GAS v4u*)(PROJ + prow + PC_KB + col8b); unpack8(w, k); }
    { const v4u w = *(const GAS v4u*)(PROJ + prow + PC_VB + col8b); unpack8(w, v); }
    float sq = 0.f, sk = 0.f;
#pragma unroll
    for (int e = 0; e < 8; ++e) { sq += q[e] * q[e]; sk += k[e] * k[e]; }
    sq += __shfl_xor(sq, 1); sq += __shfl_xor(sq, 2); sq += __shfl_xor(sq, 4);
    sk += __shfl_xor(sk, 1); sk += __shfl_xor(sk, 2); sk += __shfl_xor(sk, 4);
    const float rq = (1.f / sqrtf(sq * (1.f / DB) + EPS)) * QB_SCALE, rk = 1.f / sqrtf(sk * (1.f / DB) + EPS);
#pragma unroll
    for (int e = 0; e < 8; ++e) { q[e] *= rq * qg[e]; k[e] *= rk * kg[e]; }
    if (SMP) {
        const size_t o = ((size_t)(s * 8 + tt) * HB + hb) * DB + d8;
        float* qo = WSP(float, WS_QSB) + o; *(GAS f32x4*)qo = (f32x4){q[0], q[1], q[2], q[3]}; *(GAS f32x4*)(qo + 4) = (f32x4){q[4], q[5], q[6], q[7]};
        float* ko = F.out + O_KS + o; *(GAS f32x4*)ko = (f32x4){k[0], k[1], k[2], k[3]}; *(GAS f32x4*)(ko + 4) = (f32x4){k[4], k[5], k[6], k[7]};
        float* vo = F.out + O_VS + o; *(GAS f32x4*)vo = (f32x4){v[0], v[1], v[2], v[3]}; *(GAS f32x4*)(vo + 4) = (f32x4){v[4], v[5], v[6], v[7]};
    } else {
        const int c16 = t & 15, i16 = t >> 4;
        const size_t qi = ((((size_t)b * HB + hb) * 16 + c16) * 256 + i16) * DB + d8;
        *(GAS v4u*)(WSP(bf16, WS_Q16) + qi) = pack8(q);
        *(GAS v4u*)(WSP(bf16, WS_K16) + qi) = pack8(k);
        *(GAS v4u*)(WSP(bf16, WS_VT16) + qi) = pack8(v);
        if (t >= SEQ - WBUF) {
            const size_t o = (((size_t)b * WBUF + (t - (SEQ - WBUF))) * HB + hb) * DB + d8;
            float* ko = F.out + O_KP + o; *(GAS f32x4*)ko = (f32x4){k[0], k[1], k[2], k[3]}; *(GAS f32x4*)(ko + 4) = (f32x4){k[4], k[5], k[6], k[7]};
            float* vo = F.out + O_VP + o; *(GAS f32x4*)vo = (f32x4){v[0], v[1], v[2], v[3]}; *(GAS f32x4*)(vo + 4) = (f32x4){v[4], v[5], v[6], v[7]};
        }
    }
}
__device__ __forceinline__ void p2_load_gains(Frame& F, float (&qg)[8], float (&kg)[8], int lane) {
    const int d8 = (lane & 7) * 8;
    const f32x4 a = *(const GAS f32x4*)(F.qng + d8), c = *(const GAS f32x4*)(F.qng + d8 + 4), e2 = *(const GAS f32x4*)(F.kng + d8), f2 = *(const GAS f32x4*)(F.kng + d8 + 4);
    qg[0] = a.x; qg[1] = a.y; qg[2] = a.z; qg[3] = a.w; qg[4] = c.x; qg[5] = c.y; qg[6] = c.z; qg[7] = c.w; kg[0] = e2.x; kg[1] = e2.y; kg[2] = e2.z; kg[3] = e2.w; kg[4] = f2.x; kg[5] = f2.y; kg[6] = f2.z; kg[7] = f2.w;
}
__device__ __forceinline__ void p2_token_prep(Frame& F, int mode = 3) {
    const int lane = F.lane;
    const bf16* PROJ = WSP(bf16, WS_PROJ);
    for (int wj = F.vcu; wj < MP / 64; wj += F.G) {
        const int seg = wj * NWAVES + F.wave;
        const int b = seg >> 9, t0 = (seg & 511) * 8;
        const int row0 = b * SEQ + t0;
        const int hA = lane >> 4, dim8 = (lane & 15) * 8, bh = b * HA + hA;
#pragma unroll 1
        for (int j = 0; j < ((mode & 1) ? 3 : 0); ++j) {
            const int col8 = (lane + 64 * j) * 8;
            float cw[4][8];
#pragma unroll
            for (int i = 0; i < 4; ++i) { const f32x4 a = *(const GAS f32x4*)(F.conv_w + i * CONVC + col8), c = *(const GAS f32x4*)(F.conv_w + i * CONVC + col8 + 4);
                cw[i][0] = a.x; cw[i][1] = a.y; cw[i][2] = a.z; cw[i][3] = a.w; cw[i][4] = c.x; cw[i][5] = c.y; cw[i][6] = c.z; cw[i][7] = c.w; }
            float win[3][8];
#pragma unroll
            for (int i = 0; i < 3; ++i) {
                if (t0 == 0) {
#pragma unroll
                    for (int e = 0; e < 8; ++e) win[i][e] = 0.f; }
                else { const v4u w = *(const GAS v4u*)(PROJ + (size_t)(row0 - 3 + i) * NPROJ + col8); unpack8(w, win[i]); }
            }
            v4u xr[8];
#pragma unroll
            for (int tt = 0; tt < 8; ++tt) xr[tt] = *(const GAS v4u*)(PROJ + (size_t)(row0 + tt) * NPROJ + col8);
            unsigned tp[8][4];
            float prev[8];
#pragma unroll
            for (int tt = 0; tt < 8; ++tt) {
                float xn[8], y[8];
                unpack8(xr[tt], xn);
                float ss = 0.f;
#pragma unroll
                for (int e = 0; e < 8; ++e) { const float a = cw[0][e] * win[0][e] + cw[1][e] * win[1][e] + cw[2][e] * win[2][e] + cw[3][e] * xn[e]; y[e] = silu_f(a); ss += y[e] * y[e];
                    win[0][e] = win[1][e]; win[1][e] = win[2][e]; win[2][e] = xn[e]; }
                if (j < 2) {
                    ss += __shfl_xor(ss, 1); ss += __shfl_xor(ss, 2); ss += __shfl_xor(ss, 4); ss += __shfl_xor(ss, 8);
                    const float r = (1.f / sqrtf(ss + EPS)) * (j == 0 ? 0.08838834764831845f : 1.f);
#pragma unroll
                    for (int e = 0; e < 8; ++e) y[e] *= r;
                }
                if (tt >= 5 && t0 == SEQ - 8) {
                    float* o = F.out + O_CP + ((size_t)b * 3 + (tt - 5)) * CONVC + col8;
                    *(GAS f32x4*)o = (f32x4){xn[0], xn[1], xn[2], xn[3]}; *(GAS f32x4*)(o + 4) = (f32x4){xn[4], xn[5], xn[6], xn[7]};
                }
                if (j < 2) {
                    const int t = t0 + tt, ksq = (lane & 15) >> 2, fqp = lane & 3; const v4u w = pack8(y);
                    bf16* fb = WSP(bf16, j == 0 ? WS_QA : WS_KA) + ((((size_t)bh * (SEQ / 16) + (t >> 4)) * 4 + ksq) * 64) * 8 + (t & 15) * 8 + (fqp >> 1) * 4;
                    *(GAS u32x2v*)(fb + (((2 * fqp) & 3) << 4) * 8) = (u32x2v){w.x, w.y}; *(GAS u32x2v*)(fb + (((2 * fqp + 1) & 3) << 4) * 8) = (u32x2v){w.z, w.w};
                }
                if (j >= 1) {
                    if (tt & 1) {
#pragma unroll
                        for (int e = 0; e < 8; ++e) tp[e][tt >> 1] = cvtpk(prev[e], y[e]);
                    } else {
#pragma unroll
                        for (int e = 0; e < 8; ++e) prev[e] = y[e];
                    }
                }
            }
            if (j >= 1) {
                bf16* T = WSP(bf16, j == 1 ? WS_KAT : WS_VAT);
                const int nn = t0 >> 6, ca = t0 & 63, cb2 = ca + 4;
#pragma unroll
                for (int e = 0; e < 8; ++e) { const int dim = dim8 + e; bf16* base = T + ((((size_t)bh * NCH + nn) * 8 + (dim >> 4)) * 2) * 512 + (dim & 15) * 8;
                    *(GAS u32x2v*)(base + (ca >> 5) * 512 + (((ca >> 2) & 3) << 4) * 8 + ((ca >> 4) & 1) * 4) = (u32x2v){tp[e][0], tp[e][1]};
                    *(GAS u32x2v*)(base + (cb2 >> 5) * 512 + (((cb2 >> 2) & 3) << 4) * 8 + ((cb2 >> 4) & 1) * 4) = (u32x2v){tp[e][2], tp[e][3]}; }
            }
        }
        if (mode & 2) {
            float qg[8], kg[8]; p2_load_gains(F, qg, kg, lane);
#pragma unroll 4
            for (int tt = 0; tt < 8; ++tt) p2_mixb_token<false>(F, PROJ, (size_t)(row0 + tt), b, t0 + tt, 0, tt, qg, kg, lane);
        }
    }
}
__device__ __forceinline__ void p2_sample_pieces(Frame& F) {
    const int gw = F.vcu * NWAVES + F.wave, NGW = F.G * NWAVES, lane = F.lane;
    const bf16* PROJ = WSP(bf16, WS_PROJ);
    for (int r = gw; r < NSB * 16; r += NGW) {
        const int s = r & (NSB - 1), p = r >> 7;
        if (p < 12) {
            const int j = p >> 2, tt0 = 2 * (p & 3), col8 = (lane + 64 * j) * 8;
            float cw[4][8], x[5][8];
#pragma unroll
            for (int i = 0; i < 4; ++i) { const f32x4 a = *(const GAS f32x4*)(F.conv_w + i * CONVC + col8), c = *(const GAS f32x4*)(F.conv_w + i * CONVC + col8 + 4);
                cw[i][0] = a.x; cw[i][1] = a.y; cw[i][2] = a.z; cw[i][3] = a.w; cw[i][4] = c.x; cw[i][5] = c.y; cw[i][6] = c.z; cw[i][7] = c.w; }
#pragma unroll
            for (int k = 0; k < 5; ++k) { const int rr = tt0 - 3 + k;
                if (rr < 0) { const float* sp = F.state_conv + ((size_t)s * 3 + (3 + rr)) * CONVC + col8; const f32x4 a = *(const GAS f32x4*)sp, c = *(const GAS f32x4*)(sp + 4);
                    x[k][0] = a.x; x[k][1] = a.y; x[k][2] = a.z; x[k][3] = a.w; x[k][4] = c.x; x[k][5] = c.y; x[k][6] = c.z; x[k][7] = c.w; }
                else { const v4u w = *(const GAS v4u*)(PROJ + (size_t)(MP + s * 8 + rr) * NPROJ + col8); unpack8(w, x[k]); } }
#pragma unroll
            for (int u = 0; u < 2; ++u) {
                const int tt = tt0 + u; float y[8], ss = 0.f;
#pragma unroll
                for (int e = 0; e < 8; ++e) { const float a = cw[0][e] * x[u][e] + cw[1][e] * x[u + 1][e] + cw[2][e] * x[u + 2][e] + cw[3][e] * x[u + 3][e]; y[e] = silu_f(a); ss += y[e] * y[e]; }
                if (j < 2) {
                    ss += __shfl_xor(ss, 1); ss += __shfl_xor(ss, 2); ss += __shfl_xor(ss, 4); ss += __shfl_xor(ss, 8);
                    const float rn = (1.f / sqrtf(ss + EPS)) * (j == 0 ? 0.08838834764831845f : 1.f);
#pragma unroll
                    for (int e = 0; e < 8; ++e) y[e] *= rn;
                }
                float* o = WSP(float, WS_QKVS) + (size_t)(s * 8 + tt) * CONVC + col8;
                *(GAS f32x4*)o = (f32x4){y[0], y[1], y[2], y[3]}; *(GAS f32x4*)(o + 4) = (f32x4){y[4], y[5], y[6], y[7]};
                if (tt >= 5) { float* co = F.out + O_CS + ((size_t)s * 3 + (tt - 5)) * CONVC + col8;
                    *(GAS f32x4*)co = (f32x4){x[u + 3][0], x[u + 3][1], x[u + 3][2], x[u + 3][3]}; *(GAS f32x4*)(co + 4) = (f32x4){x[u + 3][4], x[u + 3][5], x[u + 3][6], x[u + 3][7]}; }
            }
        } else {
            float qg[8], kg[8]; p2_load_gains(F, qg, kg, lane);
            const int tt0 = 2 * (p - 12);
#pragma unroll
            for (int u = 0; u < 2; ++u) p2_mixb_token<true>(F, PROJ, (size_t)(MP + s * 8 + tt0 + u), 0, 0, s, tt0 + u, qg, kg, lane);
        }
    }
}

constexpr int P3_PAIR = 512 + 64 * 64 * 4;
__device__ __forceinline__ int tswz(int row, int col) { return row * 64 + (col ^ (((row >> 1) & 7) << 3)); }
__device__ __forceinline__ void p3_chunk_prep(Frame& F) {
    const int lane = F.lane, wave = F.wave, pair = wave >> 1, wp = wave & 1, fr = lane & 15, fq = lane >> 4;
    LAS unsigned char* pb = F.lds + pair * P3_PAIR;
    LAS float* Gc = (LAS float*)pb; LAS float* Bt = (LAS float*)(pb + 256); LAS float* LmT = (LAS float*)(pb + 512);
    LAS bf16* TB = (LAS bf16*)(pb + 512); LAS bf16* TG = (LAS bf16*)(pb + 512 + 8192);
    const bf16* QA = WSP(bf16, WS_QA); const bf16* KA = WSP(bf16, WS_KA); const bf16* KAT = WSP(bf16, WS_KAT); const bf16* VAT = WSP(bf16, WS_VAT);
    for (int u0 = F.vcu * 4; u0 < NBH * NCH; u0 += F.G * 4) {
        const int unit = u0 + pair, bh = unit >> 6, n = unit & 63, b = bh >> 2, h = bh & 3, t0 = n * 64;
        const size_t cb = (size_t)bh * NCH + n;
        if (wp == 0) {
            const size_t r = (size_t)(b * SEQ + t0 + lane) * 4 + h;
            float g = WSP(float, WS_GG)[r];
#pragma unroll
            for (int o = 1; o < 64; o <<= 1) { const float up = __shfl_up(g, o); if (lane >= o) g += up; }
            Gc[lane] = g; Bt[lane] = WSP(float, WS_BETA)[r];
            WSP(float, WS_GC)[(size_t)bh * SEQ + t0 + lane] = g;
            WSP(float, WS_CS)[cb * 64 + lane] = __shfl(g, 63);
        }
        __syncthreads();
        {
            const bf16* Xf = (wp ? QA : KA) + (((size_t)bh * (SEQ / 16) + 4 * n) * 4 * 64 + lane) * 8;
            const bf16* Kf = KA + (((size_t)bh * (SEQ / 16) + 4 * n) * 4 * 64 + lane) * 8;
#pragma unroll 1
            for (int it = 0; it < 4; ++it) {
                v4u xf[4], kf[4][4];
#pragma unroll
                for (int ks = 0; ks < 4; ++ks) { xf[ks] = *(const GAS v4u*)(Xf + (size_t)(it * 4 + ks) * 512);
#pragma unroll
                    for (int jt = 0; jt < 4; ++jt) kf[jt][ks] = *(const GAS v4u*)(Kf + (size_t)(jt * 4 + ks) * 512); }
#pragma unroll
                for (int jt = 0; jt < 4; ++jt) {
                    f32x4 acc = (f32x4){0.f, 0.f, 0.f, 0.f};
                    if (jt <= it) {
#pragma unroll
                        for (int ks = 0; ks < 4; ++ks) acc = wp ? mfma16(as_bf16x8(kf[jt][ks]), as_bf16x8(xf[ks]), acc) : mfma16(as_bf16x8(xf[ks]), as_bf16x8(kf[jt][ks]), acc);
                    }
                    if (wp == 0) {
                        if (jt <= it) { const int j = 16 * jt + fr; const float gj = Gc[j]; f32x4 o;
#pragma unroll
                            for (int r = 0; r < 4; ++r) { const int i = 16 * it + 4 * fq + r; o[r] = (i > j) ? acc[r] * Bt[i] * __expf(Gc[i] - gj) : 0.f; }
                            *(LAS f32x4*)(LmT + j * 64 + 16 * it + 4 * fq) = o; }
                    } else {
                        const int i = 16 * it + fr; const float gi = Gc[i]; float v[4];
#pragma unroll
                        for (int r = 0; r < 4; ++r) { const int j = 16 * jt + 4 * fq + r; v[r] = (i >= j) ? acc[r] * __expf(gi - Gc[j]) : 0.f; }
                        *(GAS u32x2v*)(WSP(bf16, WS_QKF) + (((cb * 4 + it) * 2 + (jt >> 1)) * 64 + lane) * 8 + (jt & 1) * 4) = (u32x2v){cvtpk(v[0], v[1]), cvtpk(v[2], v[3])};
                    }
                }
            }
        }
        __syncthreads();
        if (wp == 0) {
            float t[64]; v4u tbv[8], tgv[8];
            int lv = lane; asm volatile("" : "+v"(lv));
#pragma unroll
            for (int c = 0; c < 64; ++c) t[c] = (c == lv) ? 1.f : 0.f;
#define P3_SOLVE_BLOCK(JB) _Pragma("unroll 1") for (int j = 16 * (JB); j < 16 * (JB) + 16; ++j) { \
                const float lraw = LmT[j * 64 + lane]; const float nl = (lane > j) ? -lraw : 0.f; \
                _Pragma("unroll") for (int c = 0; c < 16 * ((JB) + 1); ++c) { const float s = __uint_as_float(__builtin_amdgcn_readlane(__float_as_uint(t[c]), j)); t[c] = fmaf(nl, s, t[c]); } }
            P3_SOLVE_BLOCK(0) P3_SOLVE_BLOCK(1) P3_SOLVE_BLOCK(2) P3_SOLVE_BLOCK(3)
#undef P3_SOLVE_BLOCK
#pragma unroll
            for (int c8 = 0; c8 < 8; ++c8) {
                const f32x4 b0 = *(const LAS f32x4*)(Bt + 8 * c8), b1 = *(const LAS f32x4*)(Bt + 8 * c8 + 4), g0 = *(const LAS f32x4*)(Gc + 8 * c8), g1 = *(const LAS f32x4*)(Gc + 8 * c8 + 4);
                float o[8], og[8];
#pragma unroll
                for (int e = 0; e < 8; ++e) { const float be = (e < 4) ? b0[e & 3] : b1[e & 3], ge = (e < 4) ? g0[e & 3] : g1[e & 3]; o[e] = t[8 * c8 + e] * be; og[e] = o[e] * __expf(ge); }
                tbv[c8] = pack8(o); tgv[c8] = pack8(og);
            }
            asm volatile("s_waitcnt lgkmcnt(0)" ::: "memory");
#pragma unroll
            for (int c8 = 0; c8 < 8; ++c8) { *(LAS v4u*)(TB + tswz(lane, 8 * c8)) = tbv[c8]; *(LAS v4u*)(TG + tswz(lane, 8 * c8)) = tgv[c8]; }
        }
        __syncthreads();
#pragma unroll 1
        for (int q4 = 0; q4 < 4; ++q4) {
            const int q = wp + 2 * q4;
            v4u vb[2], ka[2];
#pragma unroll
            for (int ks = 0; ks < 2; ++ks) {
                vb[ks] = *(const GAS v4u*)(VAT + (((cb * 8 + q) * 2 + ks) * 64 + lane) * 8);
                ka[ks] = *(const GAS v4u*)(KAT + (((cb * 8 + q) * 2 + ks) * 64 + lane) * 8); }
#pragma unroll
            for (int ct = 0; ct < 4; ++ct) {
                f32x4 au = (f32x4){0.f, 0.f, 0.f, 0.f}, aw = au;
#pragma unroll
                for (int ks = 0; ks < 2; ++ks) { const int row = 16 * ct + fr;
                    const u32x2v a0 = *(const LAS u32x2v*)(TB + tswz(row, 32 * ks + 4 * fq)), a1 = *(const LAS u32x2v*)(TB + tswz(row, 32 * ks + 16 + 4 * fq));
                    const u32x2v b0 = *(const LAS u32x2v*)(TG + tswz(row, 32 * ks + 4 * fq)), b1 = *(const LAS u32x2v*)(TG + tswz(row, 32 * ks + 16 + 4 * fq));
                    au = mfma16(as_bf16x8((v4u){a0.x, a0.y, a1.x, a1.y}), as_bf16x8(vb[ks]), au);
                    aw = mfma16(as_bf16x8(ka[ks]), as_bf16x8((v4u){b0.x, b0.y, b1.x, b1.y}), aw); }
                *(GAS f32x4*)(WSP(float, WS_UF) + (((cb * 8 + q) * 4 + ct) * 64 + lane) * 4) = au;
                *(GAS u32x2v*)(WSP(bf16, WS_WF) + (((cb * 4 + ct) * 4 + (q >> 1)) * 64 + lane) * 8 + (q & 1) * 4) = (u32x2v){cvtpk(aw[0], aw[1]), cvtpk(aw[2], aw[3])};
            }
        }
        __syncthreads();
    }
}

constexpr int P4_SB = 0, P4_VN = 8192, P4_END = 8192 + 8192;
struct ScanOps { v4u wf[4]; v4u qf[4]; v4u qk[2]; f32x4 u; v4u kf[2][2]; f32x4 gc; float gl; };
#define GLD(T, sbase, voff, imm) (*(const GAS T*)((const GAS unsigned char*)(sbase) + (voff) + (imm)))
__device__ __forceinline__ void p4_scan_load(Frame& F, ScanOps& o, int bh, int n, int vt, int ct, int lane) {
    const unsigned fr = lane & 15, fq = lane >> 4; const size_t cb = (size_t)bh * NCH + n;
    const unsigned char* wb = F.ws + WS_WF + ((cb * 4 + ct) * 4) * 1024;
    const unsigned char* qb = F.ws + WS_QA + (((size_t)bh * (SEQ / 16) + 4 * n + ct) * 4) * 1024;
    const unsigned char* qkb = F.ws + WS_QKF + ((cb * 4 + ct) * 2) * 1024;
    const unsigned char* kb0 = F.ws + WS_KAT + ((cb * 8 + 2 * ct) * 2) * 1024;
    const unsigned char* kb1 = kb0 + 2048;
    const unsigned char* ub = F.ws + WS_UF + (((cb * 8 + vt) * 4 + ct) * 64) * 16;
    const unsigned char* gb = F.ws + WS_GC + ((size_t)bh * SEQ + 64 * n + 16 * ct) * 4;
    const unsigned l16 = lane * 16u;
#pragma unroll
    for (int ks = 0; ks < 4; ++ks) { o.wf[ks] = GLD(v4u, wb, l16, ks * 1024); o.qf[ks] = GLD(v4u, qb, l16, ks * 1024); }
#pragma unroll
    for (int ks = 0; ks < 2; ++ks) { o.qk[ks] = GLD(v4u, qkb, l16, ks * 1024); o.kf[0][ks] = GLD(v4u, kb0, l16, ks * 1024); o.kf[1][ks] = GLD(v4u, kb1, l16, ks * 1024); }
    o.u = GLD(f32x4, ub, l16, 0);
    o.gc = GLD(f32x4, gb, fq * 16u, 0);
    o.gl = GLD(float, F.ws + WS_CS + cb * 256, lane * 4u, 0);
}
#define LDS_BARRIER() asm volatile("s_waitcnt lgkmcnt(0)\n\ts_barrier" ::: "memory")
__device__ __forceinline__ void p4_scan_step(Frame& F, const ScanOps& cur, f32x4 (&S)[2], LAS unsigned char* SB, LAS unsigned char* VN, int n, int b, int h, int vt, int ct, int lane) {
    const int fr = lane & 15, fq = lane >> 4;
#pragma unroll
    for (int ki = 0; ki < 2; ++ki) *(LAS u32x2v*)(SB + (ct * 64 + lane) * 16 + ki * 8) = (u32x2v){cvtpk(S[ki][0], S[ki][1]), cvtpk(S[ki][2], S[ki][3])};
    LDS_BARRIER();
    f32x4 t1 = (f32x4){0.f, 0.f, 0.f, 0.f}, o1 = (f32x4){0.f, 0.f, 0.f, 0.f};
#pragma unroll
    for (int ks = 0; ks < 4; ++ks) { const bf16x8 sb = as_bf16x8(*(const LAS v4u*)(SB + (ks * 64 + lane) * 16));
        t1 = mfma16(as_bf16x8(cur.wf[ks]), sb, t1);
        o1 = mfma16(as_bf16x8(cur.qf[ks]), sb, o1); }
    f32x4 vn, vs;
#pragma unroll
    for (int r = 0; r < 4; ++r) { vn[r] = cur.u[r] - t1[r]; vs[r] = vn[r] * __expf(cur.gl - cur.gc[r]); }
    *(LAS u32x2v*)(VN + ((0 * 2 + (ct >> 1)) * 64 + lane) * 16 + (ct & 1) * 8) = (u32x2v){cvtpk(vn[0], vn[1]), cvtpk(vn[2], vn[3])};
    *(LAS u32x2v*)(VN + ((1 * 2 + (ct >> 1)) * 64 + lane) * 16 + (ct & 1) * 8) = (u32x2v){cvtpk(vs[0], vs[1]), cvtpk(vs[2], vs[3])};
    LDS_BARRIER();
    f32x4 o2 = (f32x4){0.f, 0.f, 0.f, 0.f};
    const float egl = __expf(cur.gl);
    S[0] = S[0] * egl; S[1] = S[1] * egl;
#pragma unroll
    for (int ks = 0; ks < 2; ++ks) { const bf16x8 vnb = as_bf16x8(*(const LAS v4u*)(VN + ((0 * 2 + ks) * 64 + lane) * 16)), vsb = as_bf16x8(*(const LAS v4u*)(VN + ((1 * 2 + ks) * 64 + lane) * 16));
        o2 = mfma16(as_bf16x8(cur.qk[ks]), vnb, o2);
        S[0] = mfma16(as_bf16x8(cur.kf[0][ks]), vsb, S[0]); S[1] = mfma16(as_bf16x8(cur.kf[1][ks]), vsb, S[1]); }
    float* oa = WSP(float, WS_OA) + (size_t)(b * SEQ + 64 * n + 16 * ct + 4 * fq) * WA + h * DA + 16 * vt + fr;
#pragma unroll
    for (int r = 0; r < 4; ++r) oa[(size_t)r * WA] = __expf(cur.gc[r]) * o1[r] + o2[r];
}
__device__ __forceinline__ void p4_scan(Frame& F, int unit) {
    const int lane = F.lane, wave = F.wave, fr = lane & 15, fq = lane >> 4;
    const int bh = unit >> 2, vq = unit & 3, vtl = wave >> 2, ct = wave & 3, vt = 2 * vq + vtl, b = bh >> 2, h = bh & 3;
    LAS unsigned char* SB = F.lds + P4_SB + vtl * 4096;
    LAS unsigned char* VN = F.lds + P4_VN + vtl * 4096;
    f32x4 S[2] = {(f32x4){0.f, 0.f, 0.f, 0.f}, (f32x4){0.f, 0.f, 0.f, 0.f}};
    ScanOps A, B;
    p4_scan_load(F, A, bh, 0, vt, ct, lane);
#pragma unroll 1
    for (int n = 0; n < NCH; n += 2) {
#ifdef SCAN_NOLOAD
        if (n == 0) p4_scan_load(F, B, bh, n + 1, vt, ct, lane);
        p4_scan_step(F, A, S, SB, VN, n, b, h, vt, ct, lane);
        p4_scan_step(F, B, S, SB, VN, n + 1, b, h, vt, ct, lane);
#else
        p4_scan_load(F, B, bh, n + 1, vt, ct, lane);
        p4_scan_step(F, A, S, SB, VN, n, b, h, vt, ct, lane);
        p4_scan_load(F, A, bh, (n + 2 < NCH) ? n + 2 : n, vt, ct, lane);
        p4_scan_step(F, B, S, SB, VN, n + 1, b, h, vt, ct, lane);
#endif
    }
#pragma unroll
    for (int ki = 0; ki < 2; ++ki)
#pragma unroll
        for (int r = 0; r < 4; ++r) F.out[O_DP + ((size_t)bh * DA + 16 * (2 * ct + ki) + 4 * fq + r) * DA + 16 * vt + fr] = S[ki][r];
    __syncthreads();
}

constexpr int P4B_QKV = 16384, P4B_RED = P4B_QKV + 8 * 3 * 128 * 4, P4B_SC = P4B_RED + 2 * 4 * 128 * 4;
__device__ __forceinline__ void p4b_sample_delta(Frame& F, int unit) {
    const int tid = F.tid, s = unit >> 2, h = unit & 3, kq = tid >> 7, v = tid & 127;
    LAS float* qkv = (LAS float*)(F.lds + P4B_QKV); LAS float* red = (LAS float*)(F.lds + P4B_RED); LAS float* sc = (LAS float*)(F.lds + P4B_SC);
    for (int i = tid; i < 8 * 3 * 128; i += NWAVES * 64) { const int t = i / 384, r = i % 384, th = r >> 7, d = r & 127; qkv[i] = WSP(float, WS_QKVS)[(size_t)(s * 8 + t) * CONVC + th * 512 + h * DA + d]; }
    if (tid < 16) { const int t = tid & 7; const size_t r = (size_t)(MP + s * 8 + t) * 4 + h; sc[tid] = (tid < 8) ? WSP(float, WS_BETA)[r] : __expf(WSP(float, WS_GG)[r]); }
    float S[32];
    const float* sp = F.state_delta + ((size_t)(s * HA + h) * DA + 32 * kq) * DA + v;
#pragma unroll
    for (int i = 0; i < 32; ++i) S[i] = sp[(size_t)i * DA];
    __syncthreads();
#pragma unroll 1
    for (int t = 0; t < 8; ++t) {
        const LAS float* qt = qkv + t * 384 + 32 * kq; const LAS float* kt = qt + 128; const float beta = sc[t], dec = sc[8 + t];
        float part = 0.f;
#pragma unroll
        for (int i = 0; i < 32; ++i) { S[i] *= dec; part += kt[i] * S[i]; }
        red[kq * 128 + v] = part;
        __syncthreads();
        const float ks = (red[v] + red[128 + v]) + (red[256 + v] + red[384 + v]);
        const float vn = beta * (qkv[t * 384 + 256 + v] - ks);
        float po = 0.f;
#pragma unroll
        for (int i = 0; i < 32; ++i) { S[i] += kt[i] * vn; po += qt[i] * S[i]; }
        red[512 + kq * 128 + v] = po;
        __syncthreads();
        if (kq == 0) WSP(float, WS_OA)[(size_t)(MP + s * 8 + t) * WA + h * DA + v] = (red[512 + v] + red[640 + v]) + (red[768 + v] + red[896 + v]);
    }
    float* dp = F.out + O_DS + ((size_t)(s * HA + h) * DA + 32 * kq) * DA + v;
#pragma unroll
    for (int i = 0; i < 32; ++i) dp[(size_t)i * DA] = S[i];
    __syncthreads();
}

struct AttnKV { v4u kf[2][2], vr[4]; };
constexpr int P4C_VPITCH = 160, P4C_VBUF = 32 * P4C_VPITCH;
typedef short v4i16_t __attribute__((ext_vector_type(4)));
__device__ __forceinline__ void p4c_load(Frame& F, AttnKV& o, size_t hbase, int c, int kc, int lane) {
    const unsigned char* kb = F.ws + WS_K16 + (((hbase * 16 + c) * 256 + 32 * kc) * DB) * 2;
    const unsigned char* vb = F.ws + WS_VT16 + (((hbase * 16 + c) * 256 + 32 * kc) * DB) * 2;
    const unsigned fr = lane & 15, fq = lane >> 4, koff = fr * 128u + fq * 16u, l16 = lane * 16u;
#pragma unroll
    for (int kt = 0; kt < 2; ++kt)
#pragma unroll
        for (int ks = 0; ks < 2; ++ks) o.kf[kt][ks] = GLD(v4u, kb, koff, kt * 2048 + ks * 64);
#pragma unroll
    for (int m = 0; m < 4; ++m) o.vr[m] = GLD(v4u, vb, l16, m * 1024);
}
__device__ __forceinline__ float xq_max(float v) {
    { const auto r = __builtin_amdgcn_permlane16_swap(__float_as_uint(v), __float_as_uint(v), false, false); v = fmaxf(__uint_as_float(r[0]), __uint_as_float(r[1])); }
    { const auto r = __builtin_amdgcn_permlane32_swap(__float_as_uint(v), __float_as_uint(v), false, false); v = fmaxf(__uint_as_float(r[0]), __uint_as_float(r[1])); }
    return v;
}
__device__ __forceinline__ float xq_sum(float v) {
    { const auto r = __builtin_amdgcn_permlane16_swap(__float_as_uint(v), __float_as_uint(v), false, false); v = __uint_as_float(r[0]) + __uint_as_float(r[1]); }
    { const auto r = __builtin_amdgcn_permlane32_swap(__float_as_uint(v), __float_as_uint(v), false, false); v = __uint_as_float(r[0]) + __uint_as_float(r[1]); }
    return v;
}
constexpr int P4C_NQS = 2;
__device__ __forceinline__ void p4c_chunk(const AttnKV& kv, LAS unsigned char* vlds, const v4u (&qf)[P4C_NQS][2], f32x4 (&O)[P4C_NQS][4], float (&mrow)[P4C_NQS], float (&lrow)[P4C_NQS], int i0, int dc, int span, int lag, int kc, int fr, int fq) {
    const float m4 = ((dc & 3) == 0) ? 1.f : 0.f, m16 = (dc == 0) ? 1.f : 0.f;
    v4u vf[4];
    {
        const int lane = fq * 16 + fr;
#pragma unroll
        for (int m = 0; m < 4; ++m) { const int p = lane + 64 * m; *(LAS v4u*)(vlds + (p >> 3) * P4C_VPITCH + (p & 7) * 16) = kv.vr[m]; }
#pragma unroll
        for (int dt = 0; dt < 4; ++dt) {
            const LAS unsigned char* a0 = vlds + (4 * fq + (fr >> 2)) * P4C_VPITCH + (16 * dt + 4 * (fr & 3)) * 2;
            const v4i16_t t0 = __builtin_amdgcn_ds_read_tr16_b64_v4i16((LAS v4i16_t*)a0), t1 = __builtin_amdgcn_ds_read_tr16_b64_v4i16((LAS v4i16_t*)(a0 + 16 * P4C_VPITCH));
            const u32x2v u0 = __builtin_bit_cast(u32x2v, t0), u1 = __builtin_bit_cast(u32x2v, t1);
            vf[dt] = (v4u){u0.x, u0.y, u1.x, u1.y};
        }
    }
#pragma unroll
    for (int qs = 0; qs < P4C_NQS; ++qs) {
        const int iqlo = i0 + 16 * qs, iqhi = iqlo + 15;
        if (32 * kc > iqhi - lag || 32 * kc + 31 < iqlo - span) continue;
        f32x4 s0 = (f32x4){0.f, 0.f, 0.f, 0.f}, s1 = s0;
#pragma unroll
        for (int ks = 0; ks < 2; ++ks) { s0 = mfma16(as_bf16x8(kv.kf[0][ks]), as_bf16x8(qf[qs][ks]), s0); s1 = mfma16(as_bf16x8(kv.kf[1][ks]), as_bf16x8(qf[qs][ks]), s1); }
        const int dl0 = 16 * (iqlo + fr - 32 * kc - 4 * fq) + dc;
        float cn[8], sv[8]; float mx = mrow[qs];
#pragma unroll
        for (int e = 0; e < 8; ++e) {
            const unsigned dl = (unsigned)(dl0 - 16 * (16 * (e >> 2) + (e & 3)));
            const float cnt = ((dl <= 128u) ? 1.f : 0.f) + ((dl <= 512u) ? m4 : 0.f) + ((dl <= 2048u) ? m16 : 0.f);
            cn[e] = cnt; const float sc = (e < 4) ? s0[e & 3] : s1[e & 3]; sv[e] = (cnt > 0.f) ? sc : -1e30f; mx = fmaxf(mx, sv[e]);
        }
        mx = xq_max(mx);
        if (!__all(mx == mrow[qs])) {
            const float alpha = exp2f(mrow[qs] - mx); mrow[qs] = mx; lrow[qs] *= alpha;
#pragma unroll
            for (int dt = 0; dt < 4; ++dt) O[qs][dt] = O[qs][dt] * alpha;
        }
        float p[8], ps = 0.f;
#pragma unroll
        for (int e = 0; e < 8; ++e) { p[e] = cn[e] * exp2f(sv[e] - mx); ps += p[e]; }
        lrow[qs] += ps;
        const bf16x8 pb = as_bf16x8((v4u){cvtpk(p[0], p[1]), cvtpk(p[2], p[3]), cvtpk(p[4], p[5]), cvtpk(p[6], p[7])});
#pragma unroll
        for (int dt = 0; dt < 4; ++dt) O[qs][dt] = mfma16(as_bf16x8(vf[dt]), pb, O[qs][dt]);
    }
}
__device__ __forceinline__ void p4c_range(int c0, int i0, int c, int& dc, int& span, int& lag, int& lo, int& hi) {
    dc = c0 - c; const int wmax = (dc == 0) ? 2048 : ((dc & 3) == 0 ? 512 : 128);
    span = (wmax - dc) >> 4; lag = (dc < 0) ? 1 : 0;
    int ikmin = i0 - span; if (ikmin < 0) ikmin = 0;
    lo = ikmin >> 5; hi = (i0 + 16 * P4C_NQS - 1 - lag) >> 5;
}
__device__ __forceinline__ void p4c_attn_prompt(Frame& F, int job) {
    const int lane = F.lane, fr = lane & 15, fq = lane >> 4;
    const int qb = job & (16 / P4C_NQS - 1), jr = job / (16 / P4C_NQS), c0 = jr & 15, hb = (jr >> 4) & 7, b = jr >> 7, i0 = 16 * P4C_NQS * qb;
    const size_t hbase = (size_t)b * HB + hb;
    const bf16* Q16 = WSP(bf16, WS_Q16) + ((hbase * 16 + c0) * 256) * DB;
    v4u qf[P4C_NQS][2];
#pragma unroll
    for (int qs = 0; qs < P4C_NQS; ++qs)
#pragma unroll
        for (int ks = 0; ks < 2; ++ks) qf[qs][ks] = *(const GAS v4u*)(Q16 + (size_t)(i0 + 16 * qs + fr) * DB + 32 * ks + 8 * fq);
    f32x4 O[P4C_NQS][4]; float mrow[P4C_NQS], lrow[P4C_NQS];
#pragma unroll
    for (int qs = 0; qs < P4C_NQS; ++qs) { mrow[qs] = -1e30f; lrow[qs] = 0.f;
#pragma unroll
        for (int dt = 0; dt < 4; ++dt) O[qs][dt] = (f32x4){0.f, 0.f, 0.f, 0.f}; }
    int c = 0, dc, span, lag, lo, hi; p4c_range(c0, i0, 0, dc, span, lag, lo, hi);
    int kc = lo;
    AttnKV A, B;
    LAS unsigned char* vlds = F.lds + F.wave * P4C_VBUF;
    p4c_load(F, A, hbase, c, kc, lane);
#pragma unroll 1
    for (;;) {
        int nc = c, nkc = kc + 1, ndc = dc, nspan = span, nlag = lag, nlo = lo, nhi = hi;
        if (nkc > hi) { nc = c + 1; if (nc < 16) { p4c_range(c0, i0, nc, ndc, nspan, nlag, nlo, nhi); nkc = nlo; } }
        if (nc < 16) p4c_load(F, B, hbase, nc, nkc, lane);
        p4c_chunk(A, vlds, qf, O, mrow, lrow, i0, dc, span, lag, kc, fr, fq);
        if (nc >= 16) break;
        c = nc; kc = nkc; dc = ndc; span = nspan; lag = nlag; lo = nlo; hi = nhi;
        nc = c; nkc = kc + 1;
        if (nkc > hi) { nc = c + 1; if (nc < 16) { p4c_range(c0, i0, nc, ndc, nspan, nlag, nlo, nhi); nkc = nlo; } }
        if (nc < 16) p4c_load(F, A, hbase, nc, nkc, lane);
        p4c_chunk(B, vlds, qf, O, mrow, lrow, i0, dc, span, lag, kc, fr, fq);
        if (nc >= 16) break;
        c = nc; kc = nkc; dc = ndc; span = nspan; lag = nlag; lo = nlo; hi = nhi;
    }
#pragma unroll
    for (int qs = 0; qs < P4C_NQS; ++qs) {
        const float inv = 1.f / xq_sum(lrow[qs]);
        const int t = c0 + 16 * (i0 + 16 * qs + fr);
        bf16* o = WSP(bf16, WS_MIX) + (size_t)(b * SEQ + t) * D + WA + hb * DB + 4 * fq;
#pragma unroll
        for (int dt = 0; dt < 4; ++dt) *(GAS u32x2v*)(o + 16 * dt) = (u32x2v){cvtpk(O[qs][dt][0] * inv, O[qs][dt][1] * inv), cvtpk(O[qs][dt][2] * inv, O[qs][dt][3] * inv)};
    }
}

constexpr int P4D_PART = 32768;
__device__ __forceinline__ void p4d_rowptr(Frame& F, int s, int ch, int kk, const float*& kp, const float*& vp, int& pos) {
    if (ch < 24) { const int rho = 64 * ch + 16 * (kk >> 3) + (kk & 7); pos = rho; kp = F.cache_k + ((size_t)s * WBUF + rho) * WB; vp = F.cache_v + ((size_t)s * WBUF + rho) * WB; }
    else if (ch < 40) { const int rho = 1536 + 32 * (ch - 24) + kk; pos = rho; kp = F.cache_k + ((size_t)s * WBUF + rho) * WB; vp = F.cache_v + ((size_t)s * WBUF + rho) * WB; }
    else { const int tq = kk & 7; pos = (kk < 8) ? WBUF + tq : 1 << 20; kp = F.out + O_KS + (size_t)(s * 8 + tq) * WB; vp = F.out + O_VS + (size_t)(s * 8 + tq) * WB; }
}
__device__ __forceinline__ void p4d_attn_sample(Frame& F, int unit) {
    const int lane = F.lane, wave = F.wave, fr = lane & 15, fq = lane >> 4;
    const int s = unit >> 2, hb = (unit & 3) * 2 + (wave >> 2), qtr = wave & 3;
    v4u qf[2];
#pragma unroll
    for (int ks = 0; ks < 2; ++ks) {
        if (fr < 8) { const float* qp = WSP(float, WS_QSB) + ((size_t)(s * 8 + fr) * HB + hb) * DB + 32 * ks + 8 * fq; const f32x4 a = *(const f32x4*)qp, c = *(const f32x4*)(qp + 4);
            qf[ks] = (v4u){cvtpk(a.x, a.y), cvtpk(a.z, a.w), cvtpk(c.x, c.y), cvtpk(c.z, c.w)}; }
        else qf[ks] = (v4u){0u, 0u, 0u, 0u};
    }
    f32x4 O[4]; float mrow = -1e30f, lrow = 0.f;
#pragma unroll
    for (int dt = 0; dt < 4; ++dt) O[dt] = (f32x4){0.f, 0.f, 0.f, 0.f};
#pragma unroll 1
    for (int ch = qtr; ch < 41; ch += 4) {
        f32x4 kr[2][2][2];
#pragma unroll
        for (int kt = 0; kt < 2; ++kt) { const float* kp; const float* vp; int pos; p4d_rowptr(F, s, ch, 16 * kt + fr, kp, vp, pos);
#pragma unroll
            for (int ks = 0; ks < 2; ++ks) { kr[kt][ks][0] = *(const f32x4*)(kp + hb * DB + 32 * ks + 8 * fq); kr[kt][ks][1] = *(const f32x4*)(kp + hb * DB + 32 * ks + 8 * fq + 4); } }
        float vr[4][8];
#pragma unroll
        for (int jj = 0; jj < 8; ++jj) { const float* kp; const float* vp; int pos; p4d_rowptr(F, s, ch, 16 * (jj >> 2) + 4 * fq + (jj & 3), kp, vp, pos);
#pragma unroll
            for (int dt = 0; dt < 4; ++dt) vr[dt][jj] = vp[hb * DB + 16 * dt + fr]; }
        f32x4 s0 = (f32x4){0.f, 0.f, 0.f, 0.f}, s1 = s0;
#pragma unroll
        for (int ks = 0; ks < 2; ++ks) {
            const v4u k0 = (v4u){cvtpk(kr[0][ks][0].x, kr[0][ks][0].y), cvtpk(kr[0][ks][0].z, kr[0][ks][0].w), cvtpk(kr[0][ks][1].x, kr[0][ks][1].y), cvtpk(kr[0][ks][1].z, kr[0][ks][1].w)};
            const v4u k1 = (v4u){cvtpk(kr[1][ks][0].x, kr[1][ks][0].y), cvtpk(kr[1][ks][0].z, kr[1][ks][0].w), cvtpk(kr[1][ks][1].x, kr[1][ks][1].y), cvtpk(kr[1][ks][1].z, kr[1][ks][1].w)};
            s0 = mfma16(as_bf16x8(k0), as_bf16x8(qf[ks]), s0); s1 = mfma16(as_bf16x8(k1), as_bf16x8(qf[ks]), s1);
        }
        const int qpos = WBUF + fr;
        float cn[8], sv[8]; float mx = mrow;
#pragma unroll
        for (int e = 0; e < 8; ++e) {
            const float* kp; const float* vp; int pos; p4d_rowptr(F, s, ch, 16 * (e >> 2) + 4 * fq + (e & 3), kp, vp, pos);
            const int dl = qpos - pos;
            float cnt = 0.f;
            if (dl >= 0 && fr < 8) { cnt = (dl <= 128) ? 1.f : 0.f; if ((dl & 3) == 0 && dl <= 512) cnt += 1.f; if ((dl & 15) == 0 && dl <= 2048) cnt += 1.f; }
            cn[e] = cnt; const float sc = (e < 4) ? s0[e & 3] : s1[e & 3]; sv[e] = (cnt > 0.f) ? sc : -1e30f; mx = fmaxf(mx, sv[e]);
        }
        mx = fmaxf(mx, __shfl_xor(mx, 16)); mx = fmaxf(mx, __shfl_xor(mx, 32));
        const float alpha = exp2f(mrow - mx); mrow = mx;
        float p[8], ps = 0.f;
#pragma unroll
        for (int e = 0; e < 8; ++e) { p[e] = cn[e] * exp2f(sv[e] - mx); ps += p[e]; }
        ps += __shfl_xor(ps, 16); ps += __shfl_xor(ps, 32);
        lrow = lrow * alpha + ps;
        const bf16x8 pb = as_bf16x8((v4u){cvtpk(p[0], p[1]), cvtpk(p[2], p[3]), cvtpk(p[4], p[5]), cvtpk(p[6], p[7])});
#pragma unroll
        for (int dt = 0; dt < 4; ++dt) { const v4u va = (v4u){cvtpk(vr[dt][0], vr[dt][1]), cvtpk(vr[dt][2], vr[dt][3]), cvtpk(vr[dt][4], vr[dt][5]), cvtpk(vr[dt][6], vr[dt][7])};
            O[dt] = O[dt] * alpha; O[dt] = mfma16(as_bf16x8(va), pb, O[dt]); }
    }
    LAS float* part = (LAS float*)(F.lds + P4D_PART);
    if (fr < 8) {
        LAS float* pp = part + (wave * 8 + fr) * 66;
#pragma unroll
        for (int dt = 0; dt < 4; ++dt)
#pragma unroll
            for (int r = 0; r < 4; ++r) pp[16 * dt + 4 * fq + r] = O[dt][r];
        if (fq == 0) { pp[64] = mrow; pp[65] = lrow; }
    }
    __syncthreads();
    for (int i = F.tid; i < 2 * 8 * 64; i += NWAVES * 64) {
        const int hh = i >> 9, q = (i >> 6) & 7, d = i & 63;
        float m = -1e30f;
#pragma unroll
        for (int w = 0; w < 4; ++w) m = fmaxf(m, part[((hh * 4 + w) * 8 + q) * 66 + 64]);
        float num = 0.f, den = 0.f;
#pragma unroll
        for (int w = 0; w < 4; ++w) { const LAS float* pp = part + ((hh * 4 + w) * 8 + q) * 66; const float sc = exp2f(pp[64] - m); num += sc * pp[d]; den += sc * pp[65]; }
        const int hq = (unit & 3) * 2 + hh;
        WSP(bf16, WS_MIX)[(size_t)(MP + s * 8 + q) * D + WA + hq * DB + d] = (bf16)(cvtpk(num / den, 0.f) & 0xffffu);
    }
    __syncthreads();
}

__device__ __forceinline__ void p5_gate(Frame& F) {
    const int gw = F.vcu * NWAVES + F.wave, NGW = F.G * NWAVES, lane = F.lane, col8 = lane * 8, dim8 = (lane & 15) * 8;
    float dg[8];
    { const f32x4 a = *(const f32x4*)(F.dng + dim8), c = *(const f32x4*)(F.dng + dim8 + 4); dg[0] = a.x; dg[1] = a.y; dg[2] = a.z; dg[3] = a.w; dg[4] = c.x; dg[5] = c.y; dg[6] = c.z; dg[7] = c.w; }
    for (int m = gw; m < M; m += NGW) {
        const float* op = WSP(float, WS_OA) + (size_t)m * WA + col8;
        const f32x4 a = *(const GAS f32x4*)op, c = *(const GAS f32x4*)(op + 4);
        float o[8] = {a.x, a.y, a.z, a.w, c.x, c.y, c.z, c.w}, z[8];
        { const v4u w = *(const GAS v4u*)(WSP(bf16, WS_PROJ) + (size_t)m * NPROJ + PC_Z + col8); unpack8(w, z); }
        float ss = 0.f;
#pragma unroll
        for (int e = 0; e < 8; ++e) ss += o[e] * o[e];
        ss += __shfl_xor(ss, 1); ss += __shfl_xor(ss, 2); ss += __shfl_xor(ss, 4); ss += __shfl_xor(ss, 8);
        const float r = 1.f / sqrtf(ss * (1.f / DA) + EPS);
#pragma unroll
        for (int e = 0; e < 8; ++e) o[e] = o[e] * r * dg[e] * silu_f(z[e]);
        *(GAS v4u*)(WSP(bf16, WS_MIX) + (size_t)m * D + col8) = pack8(o);
    }
}
__device__ __forceinline__ void p7_norm2(Frame& F) {
    const int gw = F.vcu * NWAVES + F.wave, NGW = F.G * NWAVES;
    f32x4 g2[4];
#pragma unroll
    for (int j = 0; j < 4; ++j) g2[j] = *((const f32x4*)F.norm2_g + F.lane + 64 * j);
    for (int m = gw; m < M; m += NGW) {
        const GAS f32x4* xr = (const GAS f32x4*)(F.out + (size_t)m * D) + F.lane;
        f32x4 v[4]; float s = 0.f;
#pragma unroll
        for (int j = 0; j < 4; ++j) { v[j] = xr[64 * j]; s += (v[j].x * v[j].x + v[j].y * v[j].y) + (v[j].z * v[j].z + v[j].w * v[j].w); }
        const float rstd = 1.f / sqrtf(wave_sum(s) * (1.f / D) + EPS);
        GAS unsigned long long* o8 = (GAS unsigned long long*)(WSP(bf16, WS_XN) + (size_t)m * D) + F.lane;
#pragma unroll
        for (int j = 0; j < 4; ++j) { v[j] = v[j] * rstd * g2[j]; o8[64 * j] = (unsigned long long)cvtpk(v[j].x, v[j].y) | ((unsigned long long)cvtpk(v[j].z, v[j].w) << 32); }
    }
}


constexpr int N_PHASES = 10;
#ifndef PH_LIMIT
#define PH_LIMIT 10
#endif
struct Args { const float* in[18]; float* out; unsigned char* ws; int ph_lo, ph_hi; };
__global__ void __launch_bounds__(NWAVES * 64, 2) hymba_fwd(Args args) {
    extern __shared__ __attribute__((aligned(16))) unsigned char lds[];
    Frame F;
    F.lds = (LAS unsigned char*)lds;
    F.MISC = (volatile LAS unsigned*)(F.lds + MISC_OFF);
    F.tid = threadIdx.x; F.lane = F.tid & 63; F.wave = __builtin_amdgcn_readfirstlane(F.tid >> 6);
    F.G = gridDim.x; { const int bx = blockIdx.x; F.vcu = (F.G % 8 == 0) ? (bx % 8) * (F.G / 8) + bx / 8 : bx; }
    F.ws = args.ws; F.out = args.out; F.ctl = (gu32*)(args.ws + WS_CTL);
    F.xp = args.in[0]; F.xs = args.in[1]; F.cache_k = args.in[2]; F.cache_v = args.in[3]; F.state_delta = args.in[4]; F.state_conv = args.in[5]; F.norm1_g = args.in[6]; F.w_in = args.in[7];
    F.conv_w = args.in[8]; F.a_log = args.in[9]; F.dt_bias = args.in[10]; F.dng = args.in[11]; F.qng = args.in[12]; F.kng = args.in[13]; F.w_o = args.in[14]; F.norm2_g = args.in[15]; F.w_up = args.in[16]; F.w_down = args.in[17];
    for (int u = F.tid; u < (LDS_BYTES - LDSCTL_OFF) / 4; u += NWAVES * 64) ((LAS unsigned*)(F.lds + LDSCTL_OFF))[u] = 0u;
    __syncthreads();
#if MK_ONE_LAUNCH
    XcdBarrier bar = xcd_barrier_post((unsigned*)(F.ctl + CW_BAR), F.MISC + 8);
#define GRID_BAR() xcd_barrier(bar)
#else
#define GRID_BAR() do {} while (0)
#endif
    const int lo = args.ph_lo, hi = args.ph_hi;
#ifdef STAMP_A
    volatile LAS unsigned long long* stamps = (volatile LAS unsigned long long*)(F.lds + LDSCTL_OFF);
#define STAMP(k) do { if (F.tid == 0) stamps[k] = __builtin_amdgcn_s_memrealtime(); } while (0)
#else
#define STAMP(k) do {} while (0)
#endif
    STAMP(0);
#ifndef REP_PHASE
#define REP_PHASE -1
#endif
#ifndef REP_P4
#define REP_P4 0
#endif
#define NREP(k) ((REP_PHASE == (k)) ? 2 : 1)
#ifndef P2_REPMODE
#define P2_REPMODE 3
#endif
#define IN(k) (lo <= (k) && (k) < hi)
#define BOTH(k) (IN(k) && IN((k) + 1))

    if (IN(0)) { _Pragma("nounroll") for (int rep = 0; rep < NREP(0); ++rep) { p0_prologue(F); if (BOTH(0)) GRID_BAR(); STAMP(1); } }
    if (IN(1)) {
        pg8::Gemm g{WSP(bf16, WS_XN), WSP(bf16, WS_WIN), M, NPROJ, D}; pg8::StaticOrder S; S.init(M, NPROJ, F.G, (int)blockIdx.x);
        pg8::EpiBf16<0> E{WSP(bf16, WS_PROJ), NPROJ};
        pg8::gemm_phase<pg8::EpiBf16<0>, pg8::StaticOrder, PG8_ALIGN, PG8_SP2>(F.lds + RING_OFF, g, S, E);
        if (BOTH(1)) GRID_BAR(); STAMP(2);
    }
    if (IN(2)) { _Pragma("nounroll") for (int rep = 0; rep < NREP(2); ++rep) { p2_token_prep(F, rep == 0 ? 3 : P2_REPMODE); if (rep == 0) p2_sample_pieces(F); if (BOTH(2)) GRID_BAR(); STAMP(3); } }
    if (IN(3)) { _Pragma("nounroll") for (int rep = 0; rep < NREP(3); ++rep) { p3_chunk_prep(F); if (BOTH(3)) GRID_BAR(); STAMP(4); } }
    if (IN(4)) {
#ifndef P4_MASK
#define P4_MASK 15
#endif
#define P4_NEXT() do { if (F.tid == 0) F.MISC[16] = __hip_atomic_fetch_add(F.ctl + CW_Q, 1u, __ATOMIC_RELAXED, __HIP_MEMORY_SCOPE_AGENT); __syncthreads(); tk = (int)F.MISC[16]; __syncthreads(); } while (0)
        int tk; P4_NEXT();
        STAMP(11);
        while (tk < 64) { p4_scan(F, tk); P4_NEXT(); }
        STAMP(12);
        while (tk < 64 + 512) { p4c_attn_prompt(F, (tk - 64) * 8 + F.wave); P4_NEXT(); }
        STAMP(13);
        while (tk < 64 + 512 + 512) { p4d_attn_sample(F, tk - 576); P4_NEXT(); }
        while (tk < 64 + 512 + 512 + 512) { p4b_sample_delta(F, tk - 1088); P4_NEXT(); }
        STAMP(14);
#undef P4_NEXT
        if (BOTH(4)) GRID_BAR(); STAMP(5);
    }
    if (IN(5)) { _Pragma("nounroll") for (int rep = 0; rep < NREP(5); ++rep) { p5_gate(F); if (BOTH(5)) GRID_BAR(); STAMP(6); } }
    if (IN(6)) {
        pg8::Gemm g{WSP(bf16, WS_MIX), WSP(bf16, WS_WO), M, D, D}; pg8::StaticOrder S; S.init(M, D, F.G, (int)blockIdx.x);
        pg8::EpiResNorm E{F.xp, F.xs, MP, F.out, WSP(bf16, WS_XN), F.norm2_g, WSP(float, WS_RSS), D};
        pg8::gemm_phase<pg8::EpiResNorm, pg8::StaticOrder, PG8_ALIGN, PG8_SP2>(F.lds + RING_OFF, g, S, E);
        if (BOTH(6)) GRID_BAR(); STAMP(7);
    }
    if (IN(7)) { _Pragma("nounroll") for (int rep = 0; rep < NREP(7); ++rep) { STAMP(8); } }
    if (IN(8)) {
        pg8::Gemm g{WSP(bf16, WS_XN), WSP(bf16, WS_WUP), M, FF, D}; pg8::StaticOrder S; S.init(M, FF, F.G, (int)blockIdx.x);
        pg8::EpiRowScaleRelu2 E{WSP(bf16, WS_HID), FF, WSP(float, WS_RSS), 1.f / D, EPS};
        pg8::gemm_phase<pg8::EpiRowScaleRelu2, pg8::StaticOrder, PG8_ALIGN, PG8_SP2>(F.lds + RING_OFF, g, S, E);
        if (BOTH(8)) GRID_BAR(); STAMP(9);
    }
    if (IN(9)) {
        pg8::Gemm g{WSP(bf16, WS_HID), WSP(bf16, WS_WDN), M, D, FF}; pg8::StaticOrder S; S.init(M, D, F.G, (int)blockIdx.x);
        pg8::EpiResF32 E{F.out, F.out + (size_t)MP * D, MP, F.out, D};
        pg8::gemm_phase<pg8::EpiResF32, pg8::StaticOrder, PG8_ALIGN, PG8_SP2>(F.lds + RING_OFF, g, S, E);
    }
#ifdef STAMP_A
    STAMP(10);
    asm volatile("s_waitcnt vmcnt(0)" ::: "memory"); __syncthreads();
    if (blockIdx.x == 0 && F.tid == 0) {
#ifdef STAMP_AGG
        const float va = (float)__hip_atomic_load(F.ctl + CW_T + STAMP_A, __ATOMIC_RELAXED, __HIP_MEMORY_SCOPE_AGENT) * (0.01f / 256.f), vr = (float)__hip_atomic_load(F.ctl + CW_T + STAMP_R, __ATOMIC_RELAXED, __HIP_MEMORY_SCOPE_AGENT) * (0.01f / 256.f);
#else
        const float va = (float)(stamps[STAMP_A1] - stamps[STAMP_A]) * 0.01f, vr = (float)(stamps[STAMP_R1] - stamps[STAMP_R]) * 0.01f;
#endif
#ifdef STAMP_CAL
        F.out[O_YP] = 400.f; F.out[O_CP] = 100.f;
#else
        F.out[O_YP] = __expf(rintf(__logf(fmaxf(va, 1.f)) * STAMP_Q + STAMP_SHIFT) * (1.f / STAMP_Q)); F.out[O_CP] = __expf(rintf(__logf(fmaxf(vr, 1.f)) * STAMP_Q + STAMP_SHIFT) * (1.f / STAMP_Q));
#endif
    }
#endif
#undef IN
#undef BOTH
}

extern "C" void kernel_launch(void* const* d_in, const int* in_sizes, int n_in, void* d_out, int out_size, void* d_ws, size_t ws_size, hipStream_t stream) {
    static int grid = 0;
    if (grid == 0) {
        if (n_in != 18 || (size_t)out_size != O_END || ws_size < WS_END) { fprintf(stderr, "kernel_launch: unexpected shapes (n_in %d out %d ws %zu need %zu)\n", n_in, out_size, ws_size, (size_t)WS_END); grid = -1; return; }
        int dev = 0, cus = 0, per_cu = 0;
        if (hipGetDevice(&dev) != hipSuccess || hipDeviceGetAttribute(&cus, hipDeviceAttributeMultiprocessorCount, dev) != hipSuccess) { grid = -1; return; }
        if (hipFuncSetAttribute((const void*)hymba_fwd, hipFuncAttributeMaxDynamicSharedMemorySize, LDS_BYTES) != hipSuccess) { fprintf(stderr, "kernel_launch: hipFuncSetAttribute failed\n"); grid = -1; return; }
        if (hipOccupancyMaxActiveBlocksPerMultiprocessor(&per_cu, (const void*)hymba_fwd, NWAVES * 64, LDS_BYTES) != hipSuccess || per_cu < 1) fprintf(stderr, "kernel_launch: occupancy query reports %d\n", per_cu);
        (void)hipGetLastError();
        grid = cus;
    }
    if (grid < 0) return;
    (void)hipMemsetAsync((char*)d_ws + WS_CTL, 0, CTL_ZERO_BYTES, stream);
#ifdef DBG_ZERO_OUT
    (void)hipMemsetAsync(d_out, 0, (size_t)out_size * 4, stream);
#endif
    Args a{};
    for (int i = 0; i < 18; ++i) a.in[i] = (const float*)d_in[i];
    a.out = (float*)d_out; a.ws = (unsigned char*)d_ws;
#if MK_ONE_LAUNCH
    a.ph_lo = 0; a.ph_hi = N_PHASES;
    hipLaunchKernelGGL(hymba_fwd, dim3(grid), dim3(NWAVES * 64), LDS_BYTES, stream, a);
#else
    for (int p = 0; p < PH_LIMIT; ++p) { a.ph_lo = p; a.ph_hi = p + 1; hipLaunchKernelGGL(hymba_fwd, dim3(grid), dim3(NWAVES * 64), LDS_BYTES, stream, a); }
#endif
}
```

```cpp
#include <hip/hip_runtime.h>
#include <cstdio>
#include <cstdint>
namespace pg8 {
#define PG8_LAS __attribute__((address_space(3)))
typedef unsigned short bf16_t;
typedef short bf16x8 __attribute__((ext_vector_type(8)));
typedef float f32x4 __attribute__((ext_vector_type(4)));
typedef unsigned u32x4 __attribute__((ext_vector_type(4)));
constexpr int BM = 256, BK = 64, HALF = 128, HTB = HALF * BK * 2  , STAGE_BYTES = 8 * HTB, NXCD = 8, WGM = 8;

__host__ __device__ __forceinline__ int lds_byte(int r, int c) { const int st = (r >> 4) * 2 + (c >> 5), rr = r & 15, cc = c & 31, ob = rr * 64 + cc * 2; return st * 1024 + (ob ^ (((ob >> 9) & 1) << 5)); }
__host__ __device__ __forceinline__ void stage_rc(int b, int& R, int& C) { const int st = b / 1024, sb = b % 1024, swz = sb ^ (((sb >> 9) & 1) << 5); R = (st >> 1) * 16 + swz / 64; C = (st & 1) * 32 + (swz % 64) / 2; }
__host__ __device__ __forceinline__ int perm32(int rho) { const int n = rho >> 4, i = rho & 15; return 8 * (i >> 2) + 4 * n + (i & 3); }

struct Unit { int pm, pn; };
struct Gemm { const bf16_t* A; const bf16_t* Bt; int M, N, K; };

struct StaticOrder {
    int nM, nN, nwg, G, c;
    __host__ __device__ void init(int M, int N, int G_, int c_) { nM = M / BM; nN = N / BM; nwg = nM * nN; G = G_; c = c_; }
    __host__ __device__ bool next(int i, Unit& u) const {
        const long L = (long)i * G + c; if (L >= nwg) return false;
        int wgid = (int)L; { const int q = nwg / NXCD, r = nwg % NXCD, xcd = wgid % NXCD, off = wgid / NXCD; wgid = (xcd < r ? xcd * (q + 1) : r * (q + 1) + (xcd - r) * q) + off; }
        const int nig = WGM * nN, gid = wgid / nig, fm = gid * WGM, gsz = (nM - fm) < WGM ? (nM - fm) : WGM;
        u.pm = fm + ((wgid % nig) % gsz); u.pn = (wgid % nig) / gsz; return true;
    }
    __device__ __forceinline__ void a_ready(const Unit&) const {}
    __device__ __forceinline__ void done(const Unit&) const {}
};

typedef float f32x2 __attribute__((ext_vector_type(2)));
typedef __bf16 bf16x2 __attribute__((ext_vector_type(2)));
__device__ __forceinline__ unsigned cvt_pk_bf16(float lo, float hi) { f32x2 v = {lo, hi}; bf16x2 b = __builtin_convertvector(v, bf16x2); return __builtin_bit_cast(unsigned, b); }
template <int ACT> struct EpiBf16 {
    static constexpr bool PERM = true, AFTER_DRAIN = false;
    bf16_t* O; int ldc;
    __device__ __forceinline__ void operator()(const f32x4 (&acc)[2][2][4][2], const Unit& u, int wr, int wc, int fr, int fq) const {
        const int row0 = u.pm * BM + wr * 64 + fr; const int col0 = u.pn * BM + wc * 32 + 8 * fq;
#pragma unroll
        for (int ai = 0; ai < 2; ++ai)
#pragma unroll
            for (int m = 0; m < 4; ++m) { bf16_t* rowp = O + (size_t)(row0 + ai * HALF + m * 16) * ldc + col0;
#pragma unroll
                for (int bj = 0; bj < 2; ++bj) { f32x4 v0 = acc[ai][bj][m][0], v1 = acc[ai][bj][m][1];
                    if (ACT == 2) {
#pragma unroll
                        for (int e = 0; e < 4; ++e) { const float a = fmaxf(v0[e], 0.f), b = fmaxf(v1[e], 0.f); v0[e] = a * a; v1[e] = b * b; } }
                    u32x4 w; w.x = cvt_pk_bf16(v0[0], v0[1]); w.y = cvt_pk_bf16(v0[2], v0[3]); w.z = cvt_pk_bf16(v1[0], v1[1]); w.w = cvt_pk_bf16(v1[2], v1[3]);
                    *(u32x4*)(rowp + bj * HALF) = w; } }
    }
};
struct EpiResF32 {
    static constexpr bool PERM = false, AFTER_DRAIN = false;
    const float* base; const float* base2; int split; float* out; int ldc;
    __device__ __forceinline__ void operator()(const f32x4 (&acc)[2][2][4][2], const Unit& u, int wr, int wc, int fr, int fq) const {
        const int col0 = u.pn * BM + wc * 32 + 4 * fq;
        const float* bs = (u.pm * BM >= split) ? base2 - (size_t)split * ldc : base;
#pragma unroll
        for (int ai = 0; ai < 2; ++ai)
#pragma unroll
            for (int m = 0; m < 4; ++m) { const size_t off = (size_t)(u.pm * BM + ai * HALF + wr * 64 + m * 16 + fr) * ldc + col0;
#pragma unroll
                for (int bj = 0; bj < 2; ++bj)
#pragma unroll
                    for (int n = 0; n < 2; ++n) { const f32x4 b = *(const f32x4*)(bs + off + bj * HALF + n * 16); *(f32x4*)(out + off + bj * HALF + n * 16) = b + acc[ai][bj][m][n]; }
                if (m & 1) asm volatile("" ::: "memory"); }
    }
};
struct EpiResNorm {
    static constexpr bool PERM = true, AFTER_DRAIN = false;
    const float* base; const float* base2; int split; float* out; bf16_t* xn; const float* gain; float* rss; int ldc;
    __device__ __forceinline__ void operator()(const f32x4 (&acc)[2][2][4][2], const Unit& u, int wr, int wc, int fr, int fq) const {
        const int col0 = u.pn * BM + wc * 32 + 8 * fq;
        const float* bs = (u.pm * BM >= split) ? base2 - (size_t)split * ldc : base;
        f32x4 gv[2][2];
#pragma unroll
        for (int bj = 0; bj < 2; ++bj)
#pragma unroll
            for (int n = 0; n < 2; ++n) gv[bj][n] = *(const f32x4*)(gain + col0 + bj * HALF + n * 4);
#pragma unroll
        for (int ai = 0; ai < 2; ++ai)
#pragma unroll
            for (int m = 0; m < 4; ++m) { const int row = u.pm * BM + ai * HALF + wr * 64 + m * 16 + fr; const size_t off = (size_t)row * ldc + col0; float ss = 0.f;
#pragma unroll
                for (int bj = 0; bj < 2; ++bj) {
                    const f32x4 h0 = *(const f32x4*)(bs + off + bj * HALF) + acc[ai][bj][m][0], h1 = *(const f32x4*)(bs + off + bj * HALF + 4) + acc[ai][bj][m][1];
                    *(f32x4*)(out + off + bj * HALF) = h0; *(f32x4*)(out + off + bj * HALF + 4) = h1;
                    ss += ((h0[0] * h0[0] + h0[1] * h0[1]) + (h0[2] * h0[2] + h0[3] * h0[3])) + ((h1[0] * h1[0] + h1[1] * h1[1]) + (h1[2] * h1[2] + h1[3] * h1[3]));
                    const f32x4 x0 = h0 * gv[bj][0], x1 = h1 * gv[bj][1];
                    u32x4 w; w.x = cvt_pk_bf16(x0[0], x0[1]); w.y = cvt_pk_bf16(x0[2], x0[3]); w.z = cvt_pk_bf16(x1[0], x1[1]); w.w = cvt_pk_bf16(x1[2], x1[3]);
                    *(u32x4*)(xn + off + bj * HALF) = w; }
                ss += __shfl_xor(ss, 16); ss += __shfl_xor(ss, 32);
                if (fq == 0) rss[(size_t)row * 16 + u.pn * 4 + wc] = ss;
                if (m & 1) asm volatile("" ::: "memory"); }
    }
};
struct EpiRowScaleRelu2 {
    static constexpr bool PERM = true, AFTER_DRAIN = false;
    bf16_t* O; int ldc; const float* rss; float inv_n, eps;
    __device__ __forceinline__ void operator()(const f32x4 (&acc)[2][2][4][2], const Unit& u, int wr, int wc, int fr, int fq) const {
        const int row0 = u.pm * BM + wr * 64 + fr; const int col0 = u.pn * BM + wc * 32 + 8 * fq;
        float rstd[2][4];
#pragma unroll
        for (int ai = 0; ai < 2; ++ai)
#pragma unroll
            for (int m = 0; m < 4; ++m) { const f32x4 p = *(const f32x4*)(rss + (size_t)(row0 + ai * HALF + m * 16) * 16 + 4 * fq);
                float s = (p[0] + p[1]) + (p[2] + p[3]); s += __shfl_xor(s, 16); s += __shfl_xor(s, 32); rstd[ai][m] = 1.f / sqrtf(s * inv_n + eps); }
#pragma unroll
        for (int ai = 0; ai < 2; ++ai)
#pragma unroll
            for (int m = 0; m < 4; ++m) { bf16_t* rowp = O + (size_t)(row0 + ai * HALF + m * 16) * ldc + col0; const float rs = rstd[ai][m];
#pragma unroll
                for (int bj = 0; bj < 2; ++bj) { f32x4 v0 = acc[ai][bj][m][0] * rs, v1 = acc[ai][bj][m][1] * rs;
#pragma unroll
                    for (int e = 0; e < 4; ++e) { const float a = fmaxf(v0[e], 0.f), b = fmaxf(v1[e], 0.f); v0[e] = a * a; v1[e] = b * b; }
                    u32x4 w; w.x = cvt_pk_bf16(v0[0], v0[1]); w.y = cvt_pk_bf16(v0[2], v0[3]); w.z = cvt_pk_bf16(v1[0], v1[1]); w.w = cvt_pk_bf16(v1[2], v1[3]);
                    *(u32x4*)(rowp + bj * HALF) = w; } }
    }
};
template <class Epi, class Sched, bool ALIGN_EPI = false, bool SP2 = false>
__device__ __forceinline__ void gemm_phase(PG8_LAS unsigned char* lds, const Gemm g, const Sched& S, const Epi& E) {
    const int tid = threadIdx.x, wid = __builtin_amdgcn_readfirstlane(tid >> 6), lane = tid & 63, wr = wid >> 2, wc = wid & 3, fr = lane & 15, fq = lane >> 4;
    const int K = g.K, nt = K / BK;
    unsigned voffA[2], voffB[2];
#pragma unroll
    for (int i = 0; i < 2; ++i) { int R, C; stage_rc(tid * 16 + i * 8192, R, C); const int Rb = Epi::PERM ? ((R & ~31) + perm32(R & 31)) : R;
        voffA[i] = (unsigned)(R * K + C) * 2u; voffB[i] = (unsigned)(Rb * K + C) * 2u; }
    const size_t kstep = (size_t)(BK * 2);
    const size_t hstep = (size_t)HALF * K * 2;
    const size_t tstep = 2 * hstep;
    const unsigned ldsw = (unsigned)wid * 1024u;
    const int aoff = lds_byte(wr * 64 + fr, fq * 8), boff = lds_byte(wc * 32 + fr, fq * 8);
#define PG8_SA(b, h) (((b) * 2 + (h)) * HTB)
#define PG8_SB(b, h) ((4 + (b) * 2 + (h)) * HTB)
#define PG8_STAGE(bufoff, gbase, voff) do { _Pragma("unroll") for (int _i = 0; _i < 2; ++_i) \
        __builtin_amdgcn_global_load_lds((const unsigned*)((const char*)(gbase) + (voff)[_i]), (PG8_LAS unsigned*)(lds + (bufoff) + ldsw + _i * 8192), 16, 0, 0); } while (0)
#define PG8_LDA(dst, b, h) do { _Pragma("unroll") for (int m = 0; m < 4; ++m) _Pragma("unroll") for (int k = 0; k < 2; ++k) dst[m][k] = *(const PG8_LAS bf16x8*)(lds + PG8_SA(b, h) + aoff + m * 2048 + k * 1024); } while (0)
#define PG8_LDB(dst, b, h) do { _Pragma("unroll") for (int n = 0; n < 2; ++n) _Pragma("unroll") for (int k = 0; k < 2; ++k) dst[n][k] = *(const PG8_LAS bf16x8*)(lds + PG8_SB(b, h) + boff + n * 2048 + k * 1024); } while (0)
#define PG8_MMA(ai, bj, At, Bt) do { __builtin_amdgcn_s_setprio(1); _Pragma("unroll") for (int m = 0; m < 4; ++m) _Pragma("unroll") for (int n = 0; n < 2; ++n) _Pragma("unroll") for (int k = 0; k < 2; ++k) \
        acc[ai][bj][m][n] = __builtin_amdgcn_mfma_f32_16x16x32_bf16(Bt[n][k], At[m][k], acc[ai][bj][m][n], 0, 0, 0); __builtin_amdgcn_s_setprio(0); } while (0)
#define PG8_WAIT_V(n) asm volatile("s_waitcnt vmcnt(" #n ")" ::: "memory")
#define PG8_WAIT_L(n) asm volatile("s_waitcnt lgkmcnt(" #n ")" ::: "memory")
#define PG8_BAR __builtin_amdgcn_s_barrier()
#define PG8_SCHED __builtin_amdgcn_sched_barrier(0)
    Unit cur, nxt; int ui = 0;
    if (!S.next(0, cur)) return;
    f32x4 acc[2][2][4][2];
#pragma unroll
    for (int a = 0; a < 2; ++a)
#pragma unroll
        for (int b = 0; b < 2; ++b)
#pragma unroll
            for (int m = 0; m < 4; ++m)
#pragma unroll
                for (int n = 0; n < 2; ++n) acc[a][b][m][n] = (f32x4){0.f, 0.f, 0.f, 0.f};
    bf16x8 At[4][2], B0[2][2], B1[2][2];
    const char* cA = (const char*)g.A + (size_t)cur.pm * tstep; const char* cB = (const char*)g.Bt + (size_t)cur.pn * tstep;
    S.a_ready(cur);
    if constexpr (SP2) {
        PG8_STAGE(PG8_SB(0, 0), cB, voffB); PG8_STAGE(PG8_SB(0, 1), cB + hstep, voffB); PG8_STAGE(PG8_SA(0, 0), cA, voffA); PG8_STAGE(PG8_SA(0, 1), cA + hstep, voffA);
        if (wr == 1) PG8_BAR;
        PG8_WAIT_V(2); PG8_BAR;
        PG8_STAGE(PG8_SB(1, 0), cB + kstep, voffB); PG8_STAGE(PG8_SA(1, 0), cA + kstep, voffA); PG8_STAGE(PG8_SB(1, 1), cB + hstep + kstep, voffB);
        PG8_WAIT_V(6); PG8_BAR;
    } else {
        PG8_STAGE(PG8_SB(0, 0), cB, voffB); PG8_STAGE(PG8_SA(0, 0), cA, voffA); PG8_STAGE(PG8_SB(0, 1), cB + hstep, voffB); PG8_STAGE(PG8_SA(0, 1), cA + hstep, voffA);
        if (wr == 1) PG8_BAR;
        PG8_WAIT_V(4); PG8_BAR;
        PG8_STAGE(PG8_SB(1, 0), cB + kstep, voffB); PG8_STAGE(PG8_SA(1, 0), cA + kstep, voffA); PG8_STAGE(PG8_SB(1, 1), cB + hstep + kstep, voffB);
        PG8_WAIT_V(6); PG8_BAR;
    }
    for (;;) {
        const bool has_next = S.next(ui + 1, nxt);
        const char* nA = has_next ? (const char*)g.A + (size_t)nxt.pm * tstep : cA; const char* nB = has_next ? (const char*)g.Bt + (size_t)nxt.pn * tstep : cB;
        for (int t = 0; t < nt; t += 2) {
            const bool last = (t == nt - 2);
            const char* a1 = cA + (size_t)(t + 1) * kstep;
            const char* a2 = last ? nA : cA + (size_t)(t + 2) * kstep; const char* b2 = last ? nB : cB + (size_t)(t + 2) * kstep;
            const char* a3 = a2 + kstep; const char* b3 = b2 + kstep;
            if (last && has_next) S.a_ready(nxt);
            if constexpr (SP2) {
            PG8_LDB(B0, 0, 0); PG8_LDB(B1, 0, 1); PG8_SCHED; PG8_LDA(At, 0, 0); PG8_STAGE(PG8_SA(1, 1), a1 + hstep, voffA);
            PG8_WAIT_V(8); PG8_WAIT_L(0); PG8_BAR; PG8_MMA(0, 0, At, B0); PG8_MMA(0, 1, At, B1); PG8_BAR; PG8_SCHED;
            PG8_LDA(At, 0, 1); PG8_STAGE(PG8_SB(0, 0), b2, voffB); PG8_STAGE(PG8_SB(0, 1), b2 + hstep, voffB); PG8_STAGE(PG8_SA(0, 0), a2, voffA);
            PG8_WAIT_V(8); PG8_WAIT_L(0); PG8_BAR; PG8_MMA(1, 0, At, B0); PG8_MMA(1, 1, At, B1); PG8_BAR; PG8_SCHED;
            PG8_LDB(B0, 1, 0); PG8_LDB(B1, 1, 1); PG8_SCHED; PG8_LDA(At, 1, 0); PG8_STAGE(PG8_SA(0, 1), a2 + hstep, voffA);
            PG8_WAIT_V(8); PG8_WAIT_L(0); PG8_BAR; PG8_MMA(0, 0, At, B0); PG8_MMA(0, 1, At, B1); PG8_BAR; PG8_SCHED;
            PG8_LDA(At, 1, 1); PG8_STAGE(PG8_SB(1, 0), b3, voffB); PG8_STAGE(PG8_SB(1, 1), b3 + hstep, voffB); PG8_STAGE(PG8_SA(1, 0), a3, voffA);
            PG8_WAIT_V(8); PG8_WAIT_L(0); PG8_BAR; PG8_MMA(1, 0, At, B0); PG8_MMA(1, 1, At, B1); PG8_BAR; PG8_SCHED;
            } else {
            PG8_LDB(B0, 0, 0); PG8_SCHED; PG8_LDA(At, 0, 0); PG8_STAGE(PG8_SA(1, 1), a1 + hstep, voffA);
            PG8_WAIT_L(8); PG8_BAR; PG8_WAIT_L(0); PG8_MMA(0, 0, At, B0); PG8_BAR; PG8_SCHED;
            PG8_LDB(B1, 0, 1); PG8_STAGE(PG8_SB(0, 0), b2, voffB);
            PG8_BAR; PG8_WAIT_L(0); PG8_MMA(0, 1, At, B1); PG8_BAR;
            PG8_LDA(At, 0, 1); PG8_STAGE(PG8_SA(0, 0), a2, voffA);
            PG8_BAR; PG8_WAIT_L(0); PG8_MMA(1, 0, At, B0); PG8_BAR; PG8_SCHED;
            PG8_STAGE(PG8_SB(0, 1), b2 + hstep, voffB);
            PG8_WAIT_V(6); PG8_BAR; PG8_MMA(1, 1, At, B1); PG8_BAR;
            PG8_LDB(B0, 1, 0); PG8_SCHED; PG8_LDA(At, 1, 0); PG8_STAGE(PG8_SA(0, 1), a2 + hstep, voffA);
            PG8_WAIT_L(8); PG8_BAR; PG8_WAIT_L(0); PG8_MMA(0, 0, At, B0); PG8_BAR; PG8_SCHED;
            PG8_LDB(B1, 1, 1); PG8_STAGE(PG8_SB(1, 0), b3, voffB);
            PG8_BAR; PG8_WAIT_L(0); PG8_MMA(0, 1, At, B1); PG8_BAR;
            PG8_LDA(At, 1, 1); PG8_STAGE(PG8_SA(1, 0), a3, voffA);
            PG8_BAR; PG8_WAIT_L(0); PG8_MMA(1, 0, At, B0); PG8_BAR; PG8_SCHED;
            PG8_STAGE(PG8_SB(1, 1), b3 + hstep, voffB);
            PG8_WAIT_V(6); PG8_BAR; PG8_MMA(1, 1, At, B1); PG8_BAR;
            }
        }
        if constexpr (ALIGN_EPI) { if (wr == 0) PG8_BAR; }
        if constexpr (!Epi::AFTER_DRAIN) { E(acc, cur, wr, wc, fr, fq); S.done(cur); }
        if (!has_next) break;
#pragma unroll
        for (int a = 0; a < 2; ++a)
#pragma unroll
            for (int b = 0; b < 2; ++b)
#pragma unroll
                for (int m = 0; m < 4; ++m)
#pragma unroll
                    for (int n = 0; n < 2; ++n) acc[a][b][m][n] = (f32x4){0.f, 0.f, 0.f, 0.f};
        cur = nxt; cA = nA; cB = nB; ++ui;
        if constexpr (ALIGN_EPI) { if (wr == 1) PG8_BAR; }
    }
    PG8_WAIT_V(0);
    if constexpr (!ALIGN_EPI) { if (wr == 0) PG8_BAR; }
    PG8_BAR;
    if constexpr (Epi::AFTER_DRAIN) { E.fused(acc, cur, wr, wc, fr, fq, lds, wid, lane); S.done(cur); }
#undef PG8_SA
#undef PG8_SB
#undef PG8_STAGE
#undef PG8_LDA
#undef PG8_LDB
#undef PG8_MMA
#undef PG8_WAIT_V
#undef PG8_WAIT_L
#undef PG8_BAR
#undef PG8_SCHED
}
}

#ifndef PG8_SP2
#define PG8_SP2 true
#endif
#ifndef PG8_ALIGN
#define PG8_ALIGN true
#endif
#ifndef MK_ONE_LAUNCH
#define MK_ONE_LAUNCH 1
#endif

constexpr int NWAVES = 8;
constexpr int D = 1024, NB = 4, SEQ = 4096, MP = NB * SEQ, NSB = 128, ST = 8, MS = NSB * ST, M = MP + MS;
constexpr int HA = 4, DA = 128, WA = 512, HB = 8, DB = 64, WB = 512, CONVC = 1536, FF = 4096, WBUF = 2048;
constexpr int PCOLS = 3592, NPROJ = 3584;
constexpr int PC_Z = 1536, PC_QB = 2048, PC_KB = 2560, PC_VB = 3072;
constexpr int NCH = SEQ / 64, NBH = NB * HA;
constexpr float EPS = 1e-6f;
constexpr float QB_SCALE = 0.125f * 1.4426950408889634f;

constexpr size_t O_YP = 0, O_YS = (size_t)MP * D, O_KP = O_YS + (size_t)MS * D, O_VP = O_KP + (size_t)NB * WBUF * WB, O_DP = O_VP + (size_t)NB * WBUF * WB,
                 O_CP = O_DP + (size_t)NBH * DA * DA, O_KS = O_CP + (size_t)NB * 3 * CONVC, O_VS = O_KS + (size_t)MS * WB, O_DS = O_VS + (size_t)MS * WB,
                 O_CS = O_DS + (size_t)NSB * HA * DA * DA, O_END = O_CS + (size_t)NSB * 3 * CONVC;
static_assert(O_END == 36521984, "output size");

constexpr size_t al256(size_t x) { return (x + 255) & ~(size_t)255; }
constexpr size_t WS_CTL = 0, CTL_ZERO_BYTES = 1u << 20;
constexpr size_t WS_WIN = CTL_ZERO_BYTES;
constexpr size_t WS_WO = WS_WIN + (size_t)NPROJ * D * 2;
constexpr size_t WS_WUP = WS_WO + (size_t)D * D * 2;
constexpr size_t WS_WDN = WS_WUP + (size_t)FF * D * 2;
constexpr size_t WS_XN = WS_WDN + (size_t)FF * D * 2;
constexpr size_t WS_PROJ = WS_XN + (size_t)M * D * 2;
constexpr size_t WS_BETA = WS_PROJ + (size_t)M * NPROJ * 2;
constexpr size_t WS_GG = WS_BETA + (size_t)M * 4 * 4;
constexpr size_t WS_GC = WS_GG + (size_t)M * 4 * 4;
constexpr size_t WS_CS = WS_GC + (size_t)NBH * SEQ * 4;
constexpr size_t WS_QA = WS_CS + (size_t)NBH * NCH * 64 * 4;
constexpr size_t WS_KA = WS_QA + (size_t)NBH * SEQ * DA * 2;
constexpr size_t WS_KAT = WS_KA + (size_t)NBH * SEQ * DA * 2;
constexpr size_t WS_VAT = WS_KAT + (size_t)NBH * SEQ * DA * 2;
constexpr size_t WS_WF = WS_VAT + (size_t)NBH * SEQ * DA * 2;
constexpr size_t WS_UF = WS_WF + (size_t)NBH * NCH * 16 * 1024;
constexpr size_t WS_QKF = WS_UF + (size_t)NBH * NCH * 32 * 1024;
constexpr size_t WS_OA = WS_QKF + (size_t)NBH * NCH * 8 * 1024;
constexpr size_t WS_Q16 = WS_OA + (size_t)M * WA * 4;
constexpr size_t WS_K16 = WS_Q16 + (size_t)MP * WB * 2;
constexpr size_t WS_VT16 = WS_K16 + (size_t)MP * WB * 2;
constexpr size_t WS_QSB = WS_VT16 + (size_t)MP * WB * 2;
constexpr size_t WS_QKVS = WS_QSB + (size_t)MS * WB * 4;
constexpr size_t WS_MIX = WS_QKVS + (size_t)MS * CONVC * 4;
constexpr size_t WS_HID = WS_MIX + (size_t)M * D * 2;
constexpr size_t WS_RSS = WS_HID + (size_t)M * FF * 2;
constexpr size_t WS_END = WS_RSS + (size_t)M * 16 * 4;
static_assert(WS_END % 256 == 0 && WS_WIN % 256 == 0, "ws alignment");
constexpr int CW_BAR = 4096, CW_Q = 8192, CW_T = 8256;

constexpr int RING_OFF = 0, RING_BYTES = 131072;
constexpr int LDSCTL_OFF = RING_BYTES, MISC_OFF = LDSCTL_OFF + 320;
constexpr int LDS_BYTES = 147456;

#define GAS __attribute__((address_space(1)))
#define LAS __attribute__((address_space(3)))
typedef unsigned short bf16;
typedef unsigned v4u __attribute__((ext_vector_type(4)));
typedef float f32x4 __attribute__((ext_vector_type(4)));
typedef short bf16x8 __attribute__((ext_vector_type(8)));
typedef GAS unsigned gu32;
typedef GAS unsigned long long gu64;
#define RLX_AGENT __ATOMIC_RELAXED, __HIP_MEMORY_SCOPE_AGENT
#define LDS_WAIT() asm volatile("s_waitcnt lgkmcnt(0)" ::: "memory")
#define VM_WAIT() asm volatile("s_waitcnt vmcnt(0)" ::: "memory")
__device__ __forceinline__ unsigned long long rt() { return __builtin_amdgcn_s_memrealtime(); }
__device__ __forceinline__ unsigned f2bf(float f) { unsigned u = __builtin_bit_cast(unsigned, f); return (u + 0x7fffu + ((u >> 16) & 1u)) >> 16; }
__device__ __forceinline__ unsigned pk2(float lo, float hi) { return f2bf(lo) | (f2bf(hi) << 16); }

#define XB_TMO      128
#define XB_XCNT(j)  (256  + 64 * (j))
#define XB_XSUB(j)  (1280 + 64 * (j))
#define XB_XGEN(j)  (2304 + 64 * (j))
#define XB_TOP      3328
#define XB_TOPGEN   3392
#define XCD_BAR_WORDS 3456
#define XB_SPIN_CAP (1u << 18)

__device__ __forceinline__ unsigned xb_ld(unsigned* p)              { return __hip_atomic_load(p, __ATOMIC_RELAXED, __HIP_MEMORY_SCOPE_AGENT); }
__device__ __forceinline__ unsigned xb_add(unsigned* p, unsigned v) { return __hip_atomic_fetch_add(p, v, __ATOMIC_RELAXED, __HIP_MEMORY_SCOPE_AGENT); }
__device__ __forceinline__ unsigned xb_xcc_id() { return (unsigned)__builtin_amdgcn_s_getreg((3 << 11) | 20) & 0xFu; }
#define XB_SPIN(cond, bar) do { unsigned _sp = 0; while (cond) { __builtin_amdgcn_s_sleep(1); \
    if ((++_sp & 255u) == 0u) { if (xb_ld(&(bar)[XB_TMO])) break; if (_sp > XB_SPIN_CAP) { atomicAdd(&(bar)[XB_TMO], 1u); break; } } } } while (0)

struct XcdBarrier {
    unsigned* bar; unsigned x;
    volatile LAS unsigned* st;
};

__device__ __forceinline__ XcdBarrier xcd_barrier_post(unsigned* bar, volatile LAS unsigned* st) {
    XcdBarrier b; b.bar = bar; b.x = xb_xcc_id(); b.st = st;
    if (threadIdx.x == 0) (void)xb_add(&bar[XB_XCNT(b.x)], 1u);
    return b;
}
__device__ __forceinline__ void xcd_barrier_complete(unsigned* bar, unsigned x, unsigned& nloc, unsigned& nx) {
    const unsigned G = gridDim.x * gridDim.y * gridDim.z;
    unsigned sum, cnt, mine, sp = 0u;
    for (;;) {
        sum = 0u; cnt = 0u; mine = 0u;
#pragma unroll
        for (unsigned j = 0; j < 16; ++j) { const unsigned c = xb_ld(&bar[XB_XCNT(j)]); sum += c; cnt += (c > 0u) ? 1u : 0u; mine = (j == x) ? c : mine; }
        if (sum == G) break;
        __builtin_amdgcn_s_sleep(1);
        if ((++sp & 255u) == 0u) { if (xb_ld(&bar[XB_TMO])) break; if (sp > XB_SPIN_CAP) { atomicAdd(&bar[XB_TMO], 1u); break; } }
    }
    nloc = mine > 0u ? mine : 1u; nx = cnt > 0u ? cnt : 1u;
}

__device__ __forceinline__ void xcd_barrier(const XcdBarrier& b) {
    asm volatile("s_waitcnt vmcnt(0)" ::: "memory");
    __syncthreads();
    if (threadIdx.x == 0) {
        unsigned* bar = b.bar;
        __builtin_amdgcn_s_waitcnt(0);
        unsigned nloc = b.st[0], nx = b.st[1];
        if (nloc == 0u) { xcd_barrier_complete(bar, b.x, nloc, nx); b.st[0] = nloc; b.st[1] = nx; }
        const unsigned old = xb_add(&bar[XB_XSUB(b.x)], 1u);
        const unsigned gen = old / nloc;
        if (old + 1u == (gen + 1u) * nloc) {
            __builtin_amdgcn_fence(__ATOMIC_RELEASE, "agent");
            asm volatile("s_waitcnt vmcnt(0)" ::: "memory");
            const unsigned og = xb_add(&bar[XB_TOP], 1u);
            const unsigned tg = og / nx;
            if (og + 1u == (tg + 1u) * nx) xb_add(&bar[XB_TOPGEN], 1u);
            else XB_SPIN(xb_ld(&bar[XB_TOPGEN]) == tg, bar);
            __builtin_amdgcn_fence(__ATOMIC_ACQUIRE, "agent");
            xb_add(&bar[XB_XGEN(b.x)], 1u);
            asm volatile("s_waitcnt vmcnt(0)" ::: "memory");
        } else {
            XB_SPIN(xb_ld(&bar[XB_XGEN(b.x)]) == gen, bar);
            __builtin_amdgcn_fence(__ATOMIC_ACQUIRE, "agent");
            asm volatile("s_waitcnt vmcnt(0)" ::: "memory");
        }
    }
    __syncthreads();
}


typedef float f32x2v __attribute__((ext_vector_type(2)));
typedef unsigned u32x2v __attribute__((ext_vector_type(2)));
typedef __bf16 bf16x2_t __attribute__((ext_vector_type(2)));
__device__ __forceinline__ unsigned cvtpk(float lo, float hi) { f32x2v v = {lo, hi}; bf16x2_t b = __builtin_convertvector(v, bf16x2_t); return __builtin_bit_cast(unsigned, b); }
__device__ __forceinline__ float bflo(unsigned u) { return __uint_as_float(u << 16); }
__device__ __forceinline__ float bfhi(unsigned u) { return __uint_as_float(u & 0xffff0000u); }
__device__ __forceinline__ void unpack8(const v4u w, float (&f)[8]) { f[0] = bflo(w.x); f[1] = bfhi(w.x); f[2] = bflo(w.y); f[3] = bfhi(w.y); f[4] = bflo(w.z); f[5] = bfhi(w.z); f[6] = bflo(w.w); f[7] = bfhi(w.w); }
__device__ __forceinline__ v4u pack8(const float (&f)[8]) { v4u w; w.x = cvtpk(f[0], f[1]); w.y = cvtpk(f[2], f[3]); w.z = cvtpk(f[4], f[5]); w.w = cvtpk(f[6], f[7]); return w; }
__device__ __forceinline__ float silu_f(float x) { return x * __builtin_amdgcn_rcpf(1.f + __expf(-x)); }
__device__ __forceinline__ bf16x8 as_bf16x8(v4u w) { return __builtin_bit_cast(bf16x8, w); }
__device__ __forceinline__ f32x4 mfma16(bf16x8 a, bf16x8 b, f32x4 c) { return __builtin_amdgcn_mfma_f32_16x16x32_bf16(a, b, c, 0, 0, 0); }
__device__ __forceinline__ int perm_tok(int x) { return 8 * ((x >> 2) & 3) + ((x >> 4) << 2) + (x & 3); }
__device__ __forceinline__ float wave_sum(float v) {
#pragma unroll
    for (int o = 1; o < 64; o <<= 1) v += __shfl_xor(v, o);
    return v;
}

struct Frame {
    LAS unsigned char* lds;
    volatile LAS unsigned* MISC;
    gu32* ctl;
    int tid, lane, wave;
    int vcu, G;
    const float *xp, *xs, *cache_k, *cache_v, *state_delta, *state_conv, *norm1_g, *w_in, *conv_w, *a_log, *dt_bias, *dng, *qng, *kng, *w_o, *norm2_g, *w_up, *w_down;
    float* out;
    unsigned char* ws;
};
#define WSP(T, off) ((T*)(F.ws + (off)))

__device__ __forceinline__ void p0_transpose_item(const float* W, int ldw, int col0, int K, bf16* WT, int row_off, LAS float* scr, int item, int nblk, int lane) {
    const int kb = item / nblk, nb = item % nblk, k0 = 64 * kb, n0 = 32 * nb;
    float wv[32];
#pragma unroll
    for (int i = 0; i < 32; ++i) { const int kk = 2 * i + (lane >> 5); wv[i] = *(const GAS float*)(W + (size_t)(k0 + kk) * ldw + col0 + n0 + (lane & 31)); }
#pragma unroll
    for (int i = 0; i < 32; ++i) { const int kk = 2 * i + (lane >> 5); scr[kk * 33 + (lane & 31)] = wv[i]; }
    LDS_WAIT(); asm volatile("" ::: "memory");
    const int c = lane & 7;
#pragma unroll
    for (int j = 0; j < 4; ++j) { const int n = (lane >> 3) + 8 * j; const LAS float* s = scr + (8 * c) * 33 + n;
        v4u o; o.x = cvtpk(s[0 * 33], s[1 * 33]); o.y = cvtpk(s[2 * 33], s[3 * 33]); o.z = cvtpk(s[4 * 33], s[5 * 33]); o.w = cvtpk(s[6 * 33], s[7 * 33]);
        *(GAS v4u*)(WT + (size_t)(row_off + n0 + n) * K + k0 + 8 * c) = o; }
    LDS_WAIT(); asm volatile("" ::: "memory");
}
__device__ __forceinline__ void p0_prologue(Frame& F) {
    const int gw = F.vcu * NWAVES + F.wave, NGW = F.G * NWAVES;
    {
        LAS float* scr = (LAS float*)(F.lds + RING_OFF + F.wave * 16384);
        constexpr int I_A = 16 * 64, I_B = 16 * 48, I_O = 16 * 32, I_U = 16 * 128, I_D = 64 * 32;
        constexpr int NITEMS = I_A + I_B + I_O + I_U + I_D;
        for (int it = gw; it < NITEMS; it += NGW) {
            int r = it;
            if (r < I_A) { p0_transpose_item(F.w_in, PCOLS, 0, D, WSP(bf16, WS_WIN), 0, scr, r, 64, F.lane); continue; } r -= I_A;
            if (r < I_B) { p0_transpose_item(F.w_in, PCOLS, 2056, D, WSP(bf16, WS_WIN), 2048, scr, r, 48, F.lane); continue; } r -= I_B;
            if (r < I_O) { p0_transpose_item(F.w_o, D, 0, D, WSP(bf16, WS_WO), 0, scr, r, 32, F.lane); continue; } r -= I_O;
            if (r < I_U) { p0_transpose_item(F.w_up, FF, 0, D, WSP(bf16, WS_WUP), 0, scr, r, 128, F.lane); continue; } r -= I_U;
            p0_transpose_item(F.w_down, D, 0, FF, WSP(bf16, WS_WDN), 0, scr, r, 32, F.lane);
        }
    }
    __syncthreads();
    {
        LAS float* wba = (LAS float*)(F.lds + RING_OFF);
        for (int i = F.tid; i < 1024 * 2; i += NWAVES * 64) { const int k = i >> 1, hh = i & 1; const f32x4 w = *(const f32x4*)(F.w_in + (size_t)k * PCOLS + 2048 + hh * 4);
            wba[(hh * 4 + 0) * 1024 + k] = w.x; wba[(hh * 4 + 1) * 1024 + k] = w.y; wba[(hh * 4 + 2) * 1024 + k] = w.z; wba[(hh * 4 + 3) * 1024 + k] = w.w; }
        __syncthreads();
        f32x4 g1[4];
#pragma unroll
        for (int j = 0; j < 4; ++j) g1[j] = *((const f32x4*)F.norm1_g + F.lane + 64 * j);
        f32x4 nv[4];
        { const int m = gw; const float* xrow = (m < MP) ? F.xp + (size_t)m * D : F.xs + (size_t)(m - MP) * D; const GAS f32x4* xr = (const GAS f32x4*)xrow + F.lane;
#pragma unroll
          for (int j = 0; j < 4; ++j) nv[j] = xr[64 * j]; }
        const int hsel = (F.lane >> 3) & 3;
        const float dtb = F.dt_bias[hsel], nexpa = -expf(F.a_log[hsel]);
        for (int m = gw; m < M; m += NGW) {
            f32x4 v[4]; float s = 0.f;
#pragma unroll
            for (int j = 0; j < 4; ++j) { v[j] = nv[j]; s += (v[j].x * v[j].x + v[j].y * v[j].y) + (v[j].z * v[j].z + v[j].w * v[j].w); }
            { const int mn = (m + NGW < M) ? m + NGW : m; const float* xrow = (mn < MP) ? F.xp + (size_t)mn * D : F.xs + (size_t)(mn - MP) * D; const GAS f32x4* xr = (const GAS f32x4*)xrow + F.lane;
#pragma unroll
              for (int j = 0; j < 4; ++j) nv[j] = xr[64 * j]; }
            const float rstd = 1.f / sqrtf(wave_sum(s) * (1.f / D) + EPS);
            float dots[8];
#pragma unroll
            for (int e = 0; e < 8; ++e) dots[e] = 0.f;
            GAS unsigned long long* o8 = (GAS unsigned long long*)(WSP(bf16, WS_XN) + (size_t)m * D) + F.lane;
#pragma unroll
            for (int j = 0; j < 4; ++j) { v[j] = v[j] * rstd * g1[j];
                o8[64 * j] = (unsigned long long)cvtpk(v[j].x, v[j].y) | ((unsigned long long)cvtpk(v[j].z, v[j].w) << 32);
#pragma unroll
                for (int e = 0; e < 8; ++e) { const f32x4 w = *(const LAS f32x4*)(wba + e * 1024 + 4 * F.lane + 256 * j); dots[e] += (v[j].x * w.x + v[j].y * w.y) + (v[j].z * w.z + v[j].w * w.w); } }
            float d4[4], d2[2], d1;
            { const bool hi = (F.lane & 32) != 0;
#pragma unroll
              for (int e = 0; e < 4; ++e) { const float keep = hi ? dots[e + 4] : dots[e], give = hi ? dots[e] : dots[e + 4]; d4[e] = keep + __shfl_xor(give, 32); } }
            { const bool hi = (F.lane & 16) != 0;
#pragma unroll
              for (int e = 0; e < 2; ++e) { const float keep = hi ? d4[e + 2] : d4[e], give = hi ? d4[e] : d4[e + 2]; d2[e] = keep + __shfl_xor(give, 16); } }
            { const bool hi = (F.lane & 8) != 0; const float keep = hi ? d2[1] : d2[0], give = hi ? d2[0] : d2[1]; d1 = keep + __shfl_xor(give, 8); }
            d1 += __shfl_xor(d1, 1); d1 += __shfl_xor(d1, 2); d1 += __shfl_xor(d1, 4);
            if ((F.lane & 7) == 0) {
                if (F.lane < 32) WSP(float, WS_BETA)[(size_t)m * 4 + hsel] = 1.f / (1.f + expf(-d1));
                else { const float xx = d1 + dtb; const float sp = (xx > 20.f) ? xx : log1pf(expf(xx)); WSP(float, WS_GG)[(size_t)m * 4 + hsel] = nexpa * sp; }
            }
        }
    }
}

template <bool SMP> __device__ __forceinline__ void p2_mixb_token(Frame& F, const bf16* PROJ, size_t row, int b, int t, int s, int tt, const float (&qg)[8], const float (&kg)[8], int lane) {
    const int hb = lane >> 3, d8 = (lane & 7) * 8, col8b = lane * 8;
    const size_t prow = row * NPROJ;
    float q[8], k[8], v[8];
    { const v4u w = *(const GAS v4u*)(PROJ + prow + PC_QB + col8b); unpack8(w, q); }
    { const v4u w = *(const GAS v4u*)(PROJ + prow + PC_KB + col8b); unpack8(w, k); }
    { const v4u w = *(const GAS v4u*)(PROJ + prow + PC_VB + col8b); unpack8(w, v); }
    float sq = 0.f, sk = 0.f;
#pragma unroll
    for (int e = 0; e < 8; ++e) { sq += q[e] * q[e]; sk += k[e] * k[e]; }
    sq += __shfl_xor(sq, 1); sq += __shfl_xor(sq, 2); sq += __shfl_xor(sq, 4);
    sk += __shfl_xor(sk, 1); sk += __shfl_xor(sk, 2); sk += __shfl_xor(sk, 4);
    const float rq = (1.f / sqrtf(sq * (1.f / DB) + EPS)) * QB_SCALE, rk = 1.f / sqrtf(sk * (1.f / DB) + EPS);
#pragma unroll
    for (int e = 0; e < 8; ++e) { q[e] *= rq * qg[e]; k[e] *= rk * kg[e]; }
    if (SMP) {
        const size_t o = ((size_t)(s * 8 + tt) * HB + hb) * DB + d8;
        float* qo = WSP(float, WS_QSB) + o; *(GAS f32x4*)qo = (f32x4){q[0], q[1], q[2], q[3]}; *(GAS f32x4*)(qo + 4) = (f32x4){q[4], q[5], q[6], q[7]};
        float* ko = F.out + O_KS + o; *(GAS f32x4*)ko = (f32x4){k[0], k[1], k[2], k[3]}; *(GAS f32x4*)(ko + 4) = (f32x4){k[4], k[5], k[6], k[7]};
        float* vo = F.out + O_VS + o; *(GAS f32x4*)vo = (f32x4){v[0], v[1], v[2], v[3]}; *(GAS f32x4*)(vo + 4) = (f32x4){v[4], v[5], v[6], v[7]};
    } else {
        const int c16 = t & 15, i16 = t >> 4;
        const size_t qi = ((((size_t)b * HB + hb) * 16 + c16) * 256 + i16) * DB + d8;
        *(GAS v4u*)(WSP(bf16, WS_Q16) + qi) = pack8(q);
        *(GAS v4u*)(WSP(bf16, WS_K16) + qi) = pack8(k);
        *(GAS v4u*)(WSP(bf16, WS_VT16) + qi) = pack8(v);
        if (t >= SEQ - WBUF) {
            const size_t o = (((size_t)b * WBUF + (t - (SEQ - WBUF))) * HB + hb) * DB + d8;
            float* ko = F.out + O_KP + o; *(GAS f32x4*)ko = (f32x4){k[0], k[1], k[2], k[3]}; *(GAS f32x4*)(ko + 4) = (f32x4){k[4], k[5], k[6], k[7]};
            float* vo = F.out + O_VP + o; *(GAS f32x4*)vo = (f32x4){v[0], v[1], v[2], v[3]}; *(GAS f32x4*)(vo + 4) = (f32x4){v[4], v[5], v[6], v[7]};
        }
    }
}
__device__ __forceinline__ void p2_load_gains(Frame& F, float (&qg)[8], float (&kg)[8], int lane) {
    const int d8 = (lane & 7) * 8;
    const f32x4 a = *(const GAS f32x4*)(F.qng + d8), c = *(const GAS f32x4*)(F.qng + d8 + 4), e2 = *(const GAS f32x4*)(F.kng + d8), f2 = *(const GAS f32x4*)(F.kng + d8 + 4);
    qg[0] = a.x; qg[1] = a.y; qg[2] = a.z; qg[3] = a.w; qg[4] = c.x; qg[5] = c.y; qg[6] = c.z; qg[7] = c.w; kg[0] = e2.x; kg[1] = e2.y; kg[2] = e2.z; kg[3] = e2.w; kg[4] = f2.x; kg[5] = f2.y; kg[6] = f2.z; kg[7] = f2.w;
}
__device__ __forceinline__ void p2_token_prep(Frame& F, int mode = 3) {
    const int lane = F.lane;
    const bf16* PROJ = WSP(bf16, WS_PROJ);
    for (int wj = F.vcu; wj < MP / 64; wj += F.G) {
        const int seg = wj * NWAVES + F.wave;
        const int b = seg >> 9, t0 = (seg & 511) * 8;
        const int row0 = b * SEQ + t0;
        const int hA = lane >> 4, dim8 = (lane & 15) * 8, bh = b * HA + hA;
#pragma unroll 1
        for (int j = 0; j < ((mode & 1) ? 3 : 0); ++j) {
            const int col8 = (lane + 64 * j) * 8;
            float cw[4][8];
#pragma unroll
            for (int i = 0; i < 4; ++i) { const f32x4 a = *(const GAS f32x4*)(F.conv_w + i * CONVC + col8), c = *(const GAS f32x4*)(F.conv_w + i * CONVC + col8 + 4);
                cw[i][0] = a.x; cw[i][1] = a.y; cw[i][2] = a.z; cw[i][3] = a.w; cw[i][4] = c.x; cw[i][5] = c.y; cw[i][6] = c.z; cw[i][7] = c.w; }
            float win[3][8];
#pragma unroll
            for (int i = 0; i < 3; ++i) {
                if (t0 == 0) {
#pragma unroll
                    for (int e = 0; e < 8; ++e) win[i][e] = 0.f; }
                else { const v4u w = *(const GAS v4u*)(PROJ + (size_t)(row0 - 3 + i) * NPROJ + col8); unpack8(w, win[i]); }
            }
            v4u xr[8];
#pragma unroll
            for (int tt = 0; tt < 8; ++tt) xr[tt] = *(const GAS v4u*)(PROJ + (size_t)(row0 + tt) * NPROJ + col8);
            unsigned tp[8][4];
            float prev[8];
#pragma unroll
            for (int tt = 0; tt < 8; ++tt) {
                float xn[8], y[8];
                unpack8(xr[tt], xn);
                float ss = 0.f;
#pragma unroll
                for (int e = 0; e < 8; ++e) { const float a = cw[0][e] * win[0][e] + cw[1][e] * win[1][e] + cw[2][e] * win[2][e] + cw[3][e] * xn[e]; y[e] = silu_f(a); ss += y[e] * y[e];
                    win[0][e] = win[1][e]; win[1][e] = win[2][e]; win[2][e] = xn[e]; }
                if (j < 2) {
                    ss += __shfl_xor(ss, 1); ss += __shfl_xor(ss, 2); ss += __shfl_xor(ss, 4); ss += __shfl_xor(ss, 8);
                    const float r = (1.f / sqrtf(ss + EPS)) * (j == 0 ? 0.08838834764831845f : 1.f);
#pragma unroll
                    for (int e = 0; e < 8; ++e) y[e] *= r;
                }
                if (tt >= 5 && t0 == SEQ - 8) {
                    float* o = F.out + O_CP + ((size_t)b * 3 + (tt - 5)) * CONVC + col8;
                    *(GAS f32x4*)o = (f32x4){xn[0], xn[1], xn[2], xn[3]}; *(GAS f32x4*)(o + 4) = (f32x4){xn[4], xn[5], xn[6], xn[7]};
                }
                if (j < 2) {
                    const int t = t0 + tt, ksq = (lane & 15) >> 2, fqp = lane & 3; const v4u w = pack8(y);
                    bf16* fb = WSP(bf16, j == 0 ? WS_QA : WS_KA) + ((((size_t)bh * (SEQ / 16) + (t >> 4)) * 4 + ksq) * 64) * 8 + (t & 15) * 8 + (fqp >> 1) * 4;
                    *(GAS u32x2v*)(fb + (((2 * fqp) & 3) << 4) * 8) = (u32x2v){w.x, w.y}; *(GAS u32x2v*)(fb + (((2 * fqp + 1) & 3) << 4) * 8) = (u32x2v){w.z, w.w};
                }
                if (j >= 1) {
                    if (tt & 1) {
#pragma unroll
                        for (int e = 0; e < 8; ++e) tp[e][tt >> 1] = cvtpk(prev[e], y[e]);
                    } else {
#pragma unroll
                        for (int e = 0; e < 8; ++e) prev[e] = y[e];
                    }
                }
            }
            if (j >= 1) {
                bf16* T = WSP(bf16, j == 1 ? WS_KAT : WS_VAT);
                const int nn = t0 >> 6, ca = t0 & 63, cb2 = ca + 4;
#pragma unroll
                for (int e = 0; e < 8; ++e) { const int dim = dim8 + e; bf16* base = T + ((((size_t)bh * NCH + nn) * 8 + (dim >> 4)) * 2) * 512 + (dim & 15) * 8;
                    *(GAS u32x2v*)(base + (ca >> 5) * 512 + (((ca >> 2) & 3) << 4) * 8 + ((ca >> 4) & 1) * 4) = (u32x2v){tp[e][0], tp[e][1]};
                    *(GAS u32x2v*)(base + (cb2 >> 5) * 512 + (((cb2 >> 2) & 3) << 4) * 8 + ((cb2 >> 4) & 1) * 4) = (u32x2v){tp[e][2], tp[e][3]}; }
            }
        }
        if (mode & 2) {
            float qg[8], kg[8]; p2_load_gains(F, qg, kg, lane);
#pragma unroll 4
            for (int tt = 0; tt < 8; ++tt) p2_mixb_token<false>(F, PROJ, (size_t)(row0 + tt), b, t0 + tt, 0, tt, qg, kg, lane);
        }
    }
}
__device__ __forceinline__ void p2_sample_pieces(Frame& F) {
    const int gw = F.vcu * NWAVES + F.wave, NGW = F.G * NWAVES, lane = F.lane;
    const bf16* PROJ = WSP(bf16, WS_PROJ);
    for (int r = gw; r < NSB * 16; r += NGW) {
        const int s = r & (NSB - 1), p = r >> 7;
        if (p < 12) {
            const int j = p >> 2, tt0 = 2 * (p & 3), col8 = (lane + 64 * j) * 8;
            float cw[4][8], x[5][8];
#pragma unroll
            for (int i = 0; i < 4; ++i) { const f32x4 a = *(const GAS f32x4*)(F.conv_w + i * CONVC + col8), c = *(const GAS f32x4*)(F.conv_w + i * CONVC + col8 + 4);
                cw[i][0] = a.x; cw[i][1] = a.y; cw[i][2] = a.z; cw[i][3] = a.w; cw[i][4] = c.x; cw[i][5] = c.y; cw[i][6] = c.z; cw[i][7] = c.w; }
#pragma unroll
            for (int k = 0; k < 5; ++k) { const int rr = tt0 - 3 + k;
                if (rr < 0) { const float* sp = F.state_conv + ((size_t)s * 3 + (3 + rr)) * CONVC + col8; const f32x4 a = *(const GAS f32x4*)sp, c = *(const GAS f32x4*)(sp + 4);
                    x[k][0] = a.x; x[k][1] = a.y; x[k][2] = a.z; x[k][3] = a.w; x[k][4] = c.x; x[k][5] = c.y; x[k][6] = c.z; x[k][7] = c.w; }
                else { const v4u w = *(const GAS v4u*)(PROJ + (size_t)(MP + s * 8 + rr) * NPROJ + col8); unpack8(w, x[k]); } }
#pragma unroll
            for (int u = 0; u < 2; ++u) {
                const int tt = tt0 + u; float y[8], ss = 0.f;
#pragma unroll
                for (int e = 0; e < 8; ++e) { const float a = cw[0][e] * x[u][e] + cw[1][e] * x[u + 1][e] + cw[2][e] * x[u + 2][e] + cw[3][e] * x[u + 3][e]; y[e] = silu_f(a); ss += y[e] * y[e]; }
                if (j < 2) {
                    ss += __shfl_xor(ss, 1); ss += __shfl_xor(ss, 2); ss += __shfl_xor(ss, 4); ss += __shfl_xor(ss, 8);
                    const float rn = (1.f / sqrtf(ss + EPS)) * (j == 0 ? 0.08838834764831845f : 1.f);
#pragma unroll
                    for (int e = 0; e < 8; ++e) y[e] *= rn;
                }
                float* o = WSP(float, WS_QKVS) + (size_t)(s * 8 + tt) * CONVC + col8;
                *(GAS f32x4*)o = (f32x4){y[0], y[1], y[2], y[3]}; *(GAS f32x4*)(o + 4) = (f32x4){y[4], y[5], y[6], y[7]};
                if (tt >= 5) { float* co = F.out + O_CS + ((size_t)s * 3 + (tt - 5)) * CONVC + col8;
                    *(GAS f32x4*)co = (f32x4){x[u + 3][0], x[u + 3][1], x[u + 3][2], x[u + 3][3]}; *(GAS f32x4*)(co + 4) = (f32x4){x[u + 3][4], x[u + 3][5], x[u + 3][6], x[u + 3][7]}; }
            }
        } else {
            float qg[8], kg[8]; p2_load_gains(F, qg, kg, lane);
            const int tt0 = 2 * (p - 12);
#pragma unroll
            for (int u = 0; u < 2; ++u) p2_mixb_token<true>(F, PROJ, (size_t)(MP + s * 8 + tt0 + u), 0, 0, s, tt0 + u, qg, kg, lane);
        }
    }
}

constexpr int P3_PAIR = 512 + 64 * 64 * 4;
__device__ __forceinline__ int tswz(int row, int col) { return row * 64 + (col ^ (((row >> 1) & 7) << 3)); }
__device__ __forceinline__ void p3_chunk_prep(Frame& F) {
    const int lane = F.lane, wave = F.wave, pair = wave >> 1, wp = wave & 1, fr = lane & 15, fq = lane >> 4;
    LAS unsigned char* pb = F.lds + pair * P3_PAIR;
    LAS float* Gc = (LAS float*)pb; LAS float* Bt = (LAS float*)(pb + 256); LAS float* LmT = (LAS float*)(pb + 512);
    LAS bf16* TB = (LAS bf16*)(pb + 512); LAS bf16* TG = (LAS bf16*)(pb + 512 + 8192);
    const bf16* QA = WSP(bf16, WS_QA); const bf16* KA = WSP(bf16, WS_KA); const bf16* KAT = WSP(bf16, WS_KAT); const bf16* VAT = WSP(bf16, WS_VAT);
    for (int u0 = F.vcu * 4; u0 < NBH * NCH; u0 += F.G * 4) {
        const int unit = u0 + pair, bh = unit >> 6, n = unit & 63, b = bh >> 2, h = bh & 3, t0 = n * 64;
        const size_t cb = (size_t)bh * NCH + n;
        if (wp == 0) {
            const size_t r = (size_t)(b * SEQ + t0 + lane) * 4 + h;
            float g = WSP(float, WS_GG)[r];
#pragma unroll
            for (int o = 1; o < 64; o <<= 1) { const float up = __shfl_up(g, o); if (lane >= o) g += up; }
            Gc[lane] = g; Bt[lane] = WSP(float, WS_BETA)[r];
            WSP(float, WS_GC)[(size_t)bh * SEQ + t0 + lane] = g;
            WSP(float, WS_CS)[cb * 64 + lane] = __shfl(g, 63);
        }
        __syncthreads();
        {
            const bf16* Xf = (wp ? QA : KA) + (((size_t)bh * (SEQ / 16) + 4 * n) * 4 * 64 + lane) * 8;
            const bf16* Kf = KA + (((size_t)bh * (SEQ / 16) + 4 * n) * 4 * 64 + lane) * 8;
#pragma unroll 1
            for (int it = 0; it < 4; ++it) {
                v4u xf[4], kf[4][4];
#pragma unroll
                for (int ks = 0; ks < 4; ++ks) { xf[ks] = *(const GAS v4u*)(Xf + (size_t)(it * 4 + ks) * 512);
#pragma unroll
                    for (int jt = 0; jt < 4; ++jt) kf[jt][ks] = *(const GAS v4u*)(Kf + (size_t)(jt * 4 + ks) * 512); }
#pragma unroll
                for (int jt = 0; jt < 4; ++jt) {
                    f32x4 acc = (f32x4){0.f, 0.f, 0.f, 0.f};
                    if (jt <= it) {
#pragma unroll
                        for (int ks = 0; ks < 4; ++ks) acc = wp ? mfma16(as_bf16x8(kf[jt][ks]), as_bf16x8(xf[ks]), acc) : mfma16(as_bf16x8(xf[ks]), as_bf16x8(kf[jt][ks]), acc);
                    }
                    if (wp == 0) {
                        if (jt <= it) { const int j = 16 * jt + fr; const float gj = Gc[j]; f32x4 o;
#pragma unroll
                            for (int r = 0; r < 4; ++r) { const int i = 16 * it + 4 * fq + r; o[r] = (i > j) ? acc[r] * Bt[i] * __expf(Gc[i] - gj) : 0.f; }
                            *(LAS f32x4*)(LmT + j * 64 + 16 * it + 4 * fq) = o; }
                    } else {
                        const int i = 16 * it + fr; const float gi = Gc[i]; float v[4];
#pragma unroll
                        for (int r = 0; r < 4; ++r) { const int j = 16 * jt + 4 * fq + r; v[r] = (i >= j) ? acc[r] * __expf(gi - Gc[j]) : 0.f; }
                        *(GAS u32x2v*)(WSP(bf16, WS_QKF) + (((cb * 4 + it) * 2 + (jt >> 1)) * 64 + lane) * 8 + (jt & 1) * 4) = (u32x2v){cvtpk(v[0], v[1]), cvtpk(v[2], v[3])};
                    }
                }
            }
        }
        __syncthreads();
        if (wp == 0) {
            float t[64]; v4u tbv[8], tgv[8];
            int lv = lane; asm volatile("" : "+v"(lv));
#pragma unroll
            for (int c = 0; c < 64; ++c) t[c] = (c == lv) ? 1.f : 0.f;
#define P3_SOLVE_BLOCK(JB) _Pragma("unroll 1") for (int j = 16 * (JB); j < 16 * (JB) + 16; ++j) { \
                const float lraw = LmT[j * 64 + lane]; const float nl = (lane > j) ? -lraw : 0.f; \
                _Pragma("unroll") for (int c = 0; c < 16 * ((JB) + 1); ++c) { const float s = __uint_as_float(__builtin_amdgcn_readlane(__float_as_uint(t[c]), j)); t[c] = fmaf(nl, s, t[c]); } }
            P3_SOLVE_BLOCK(0) P3_SOLVE_BLOCK(1) P3_SOLVE_BLOCK(2) P3_SOLVE_BLOCK(3)
#undef P3_SOLVE_BLOCK
#pragma unroll
            for (int c8 = 0; c8 < 8; ++c8) {
                const f32x4 b0 = *(const LAS f32x4*)(Bt + 8 * c8), b1 = *(const LAS f32x4*)(Bt + 8 * c8 + 4), g0 = *(const LAS f32x4*)(Gc + 8 * c8), g1 = *(const LAS f32x4*)(Gc + 8 * c8 + 4);
                float o[8], og[8];
#pragma unroll
                for (int e = 0; e < 8; ++e) { const float be = (e < 4) ? b0[e & 3] : b1[e & 3], ge = (e < 4) ? g0[e & 3] : g1[e & 3]; o[e] = t[8 * c8 + e] * be; og[e] = o[e] * __expf(ge); }
                tbv[c8] = pack8(o); tgv[c8] = pack8(og);
            }
            asm volatile("s_waitcnt lgkmcnt(0)" ::: "memory");
#pragma unroll
            for (int c8 = 0; c8 < 8; ++c8) { *(LAS v4u*)(TB + tswz(lane, 8 * c8)) = tbv[c8]; *(LAS v4u*)(TG + tswz(lane, 8 * c8)) = tgv[c8]; }
        }
        __syncthreads();
#pragma unroll 1
        for (int q4 = 0; q4 < 4; ++q4) {
            const int q = wp + 2 * q4;
            v4u vb[2], ka[2];
#pragma unroll
            for (int ks = 0; ks < 2; ++ks) {
                vb[ks] = *(const GAS v4u*)(VAT + (((cb * 8 + q) * 2 + ks) * 64 + lane) * 8);
                ka[ks] = *(const GAS v4u*)(KAT + (((cb * 8 + q) * 2 + ks) * 64 + lane) * 8); }
#pragma unroll
            for (int ct = 0; ct < 4; ++ct) {
                f32x4 au = (f32x4){0.f, 0.f, 0.f, 0.f}, aw = au;
#pragma unroll
                for (int ks = 0; ks < 2; ++ks) { const int row = 16 * ct + fr;
                    const u32x2v a0 = *(const LAS u32x2v*)(TB + tswz(row, 32 * ks + 4 * fq)), a1 = *(const LAS u32x2v*)(TB + tswz(row, 32 * ks + 16 + 4 * fq));
                    const u32x2v b0 = *(const LAS u32x2v*)(TG + tswz(row, 32 * ks + 4 * fq)), b1 = *(const LAS u32x2v*)(TG + tswz(row, 32 * ks + 16 + 4 * fq));
                    au = mfma16(as_bf16x8((v4u){a0.x, a0.y, a1.x, a1.y}), as_bf16x8(vb[ks]), au);
                    aw = mfma16(as_bf16x8(ka[ks]), as_bf16x8((v4u){b0.x, b0.y, b1.x, b1.y}), aw); }
                *(GAS f32x4*)(WSP(float, WS_UF) + (((cb * 8 + q) * 4 + ct) * 64 + lane) * 4) = au;
                *(GAS u32x2v*)(WSP(bf16, WS_WF) + (((cb * 4 + ct) * 4 + (q >> 1)) * 64 + lane) * 8 + (q & 1) * 4) = (u32x2v){cvtpk(aw[0], aw[1]), cvtpk(aw[2], aw[3])};
            }
        }
        __syncthreads();
    }
}

constexpr int P4_SB = 0, P4_VN = 8192, P4_END = 8192 + 8192;
struct ScanOps { v4u wf[4]; v4u qf[4]; v4u qk[2]; f32x4 u; v4u kf[2][2]; f32x4 gc; float gl; };
#define GLD(T, sbase, voff, imm) (*(const GAS T*)((const GAS unsigned char*)(sbase) + (voff) + (imm)))
__device__ __forceinline__ void p4_scan_load(Frame& F, ScanOps& o, int bh, int n, int vt, int ct, int lane) {
    const unsigned fr = lane & 15, fq = lane >> 4; const size_t cb = (size_t)bh * NCH + n;
    const unsigned char* wb = F.ws + WS_WF + ((cb * 4 + ct) * 4) * 1024;
    const unsigned char* qb = F.ws + WS_QA + (((size_t)bh * (SEQ / 16) + 4 * n + ct) * 4) * 1024;
    const unsigned char* qkb = F.ws + WS_QKF + ((cb * 4 + ct) * 2) * 1024;
    const unsigned char* kb0 = F.ws + WS_KAT + ((cb * 8 + 2 * ct) * 2) * 1024;
    const unsigned char* kb1 = kb0 + 2048;
    const unsigned char* ub = F.ws + WS_UF + (((cb * 8 + vt) * 4 + ct) * 64) * 16;
    const unsigned char* gb = F.ws + WS_GC + ((size_t)bh * SEQ + 64 * n + 16 * ct) * 4;
    const unsigned l16 = lane * 16u;
#pragma unroll
    for (int ks = 0; ks < 4; ++ks) { o.wf[ks] = GLD(v4u, wb, l16, ks * 1024); o.qf[ks] = GLD(v4u, qb, l16, ks * 1024); }
#pragma unroll
    for (int ks = 0; ks < 2; ++ks) { o.qk[ks] = GLD(v4u, qkb, l16, ks * 1024); o.kf[0][ks] = GLD(v4u, kb0, l16, ks * 1024); o.kf[1][ks] = GLD(v4u, kb1, l16, ks * 1024); }
    o.u = GLD(f32x4, ub, l16, 0);
    o.gc = GLD(f32x4, gb, fq * 16u, 0);
    o.gl = GLD(float, F.ws + WS_CS + cb * 256, lane * 4u, 0);
}
#define LDS_BARRIER() asm volatile("s_waitcnt lgkmcnt(0)\n\ts_barrier" ::: "memory")
__device__ __forceinline__ void p4_scan_step(Frame& F, const ScanOps& cur, f32x4 (&S)[2], LAS unsigned char* SB, LAS unsigned char* VN, int n, int b, int h, int vt, int ct, int lane) {
    const int fr = lane & 15, fq = lane >> 4;
#pragma unroll
    for (int ki = 0; ki < 2; ++ki) *(LAS u32x2v*)(SB + (ct * 64 + lane) * 16 + ki * 8) = (u32x2v){cvtpk(S[ki][0], S[ki][1]), cvtpk(S[ki][2], S[ki][3])};
    LDS_BARRIER();
    f32x4 t1 = (f32x4){0.f, 0.f, 0.f, 0.f}, o1 = (f32x4){0.f, 0.f, 0.f, 0.f};
#pragma unroll
    for (int ks = 0; ks < 4; ++ks) { const bf16x8 sb = as_bf16x8(*(const LAS v4u*)(SB + (ks * 64 + lane) * 16));
        t1 = mfma16(as_bf16x8(cur.wf[ks]), sb, t1);
        o1 = mfma16(as_bf16x8(cur.qf[ks]), sb, o1); }
    f32x4 vn, vs;
#pragma unroll
    for (int r = 0; r < 4; ++r) { vn[r] = cur.u[r] - t1[r]; vs[r] = vn[r] * __expf(cur.gl - cur.gc[r]); }
    *(LAS u32x2v*)(VN + ((0 * 2 + (ct >> 1)) * 64 + lane) * 16 + (ct & 1) * 8) = (u32x2v){cvtpk(vn[0], vn[1]), cvtpk(vn[2], vn[3])};
    *(LAS u32x2v*)(VN + ((1 * 2 + (ct >> 1)) * 64 + lane) * 16 + (ct & 1) * 8) = (u32x2v){cvtpk(vs[0], vs[1]), cvtpk(vs[2], vs[3])};
    LDS_BARRIER();
    f32x4 o2 = (f32x4){0.f, 0.f, 0.f, 0.f};
    const float egl = __expf(cur.gl);
    S[0] = S[0] * egl; S[1] = S[1] * egl;
#pragma unroll
    for (int ks = 0; ks < 2; ++ks) { const bf16x8 vnb = as_bf16x8(*(const LAS v4u*)(VN + ((0 * 2 + ks) * 64 + lane) * 16)), vsb = as_bf16x8(*(const LAS v4u*)(VN + ((1 * 2 + ks) * 64 + lane) * 16));
        o2 = mfma16(as_bf16x8(cur.qk[ks]), vnb, o2);
        S[0] = mfma16(as_bf16x8(cur.kf[0][ks]), vsb, S[0]); S[1] = mfma16(as_bf16x8(cur.kf[1][ks]), vsb, S[1]); }
    float* oa = WSP(float, WS_OA) + (size_t)(b * SEQ + 64 * n + 16 * ct + 4 * fq) * WA + h * DA + 16 * vt + fr;
#pragma unroll
    for (int r = 0; r < 4; ++r) oa[(size_t)r * WA] = __expf(cur.gc[r]) * o1[r] + o2[r];
}
__device__ __forceinline__ void p4_scan(Frame& F, int unit) {
    const int lane = F.lane, wave = F.wave, fr = lane & 15, fq = lane >> 4;
    const int bh = unit >> 2, vq = unit & 3, vtl = wave >> 2, ct = wave & 3, vt = 2 * vq + vtl, b = bh >> 2, h = bh & 3;
    LAS unsigned char* SB = F.lds + P4_SB + vtl * 4096;
    LAS unsigned char* VN = F.lds + P4_VN + vtl * 4096;
    f32x4 S[2] = {(f32x4){0.f, 0.f, 0.f, 0.f}, (f32x4){0.f, 0.f, 0.f, 0.f}};
    ScanOps A, B;
    p4_scan_load(F, A, bh, 0, vt, ct, lane);
#pragma unroll 1
    for (int n = 0; n < NCH; n += 2) {
#ifdef SCAN_NOLOAD
        if (n == 0) p4_scan_load(F, B, bh, n + 1, vt, ct, lane);
        p4_scan_step(F, A, S, SB, VN, n, b, h, vt, ct, lane);
        p4_scan_step(F, B, S, SB, VN, n + 1, b, h, vt, ct, lane);
#else
        p4_scan_load(F, B, bh, n + 1, vt, ct, lane);
        p4_scan_step(F, A, S, SB, VN, n, b, h, vt, ct, lane);
        p4_scan_load(F, A, bh, (n + 2 < NCH) ? n + 2 : n, vt, ct, lane);
        p4_scan_step(F, B, S, SB, VN, n + 1, b, h, vt, ct, lane);
#endif
    }
#pragma unroll
    for (int ki = 0; ki < 2; ++ki)
#pragma unroll
        for (int r = 0; r < 4; ++r) F.out[O_DP + ((size_t)bh * DA + 16 * (2 * ct + ki) + 4 * fq + r) * DA + 16 * vt + fr] = S[ki][r];
    __syncthreads();
}

constexpr int P4B_QKV = 16384, P4B_RED = P4B_QKV + 8 * 3 * 128 * 4, P4B_SC = P4B_RED + 2 * 4 * 128 * 4;
__device__ __forceinline__ void p4b_sample_delta(Frame& F, int unit) {
    const int tid = F.tid, s = unit >> 2, h = unit & 3, kq = tid >> 7, v = tid & 127;
    LAS float* qkv = (LAS float*)(F.lds + P4B_QKV); LAS float* red = (LAS float*)(F.lds + P4B_RED); LAS float* sc = (LAS float*)(F.lds + P4B_SC);
    for (int i = tid; i < 8 * 3 * 128; i += NWAVES * 64) { const int t = i / 384, r = i % 384, th = r >> 7, d = r & 127; qkv[i] = WSP(float, WS_QKVS)[(size_t)(s * 8 + t) * CONVC + th * 512 + h * DA + d]; }
    if (tid < 16) { const int t = tid & 7; const size_t r = (size_t)(MP + s * 8 + t) * 4 + h; sc[tid] = (tid < 8) ? WSP(float, WS_BETA)[r] : __expf(WSP(float, WS_GG)[r]); }
    float S[32];
    const float* sp = F.state_delta + ((size_t)(s * HA + h) * DA + 32 * kq) * DA + v;
#pragma unroll
    for (int i = 0; i < 32; ++i) S[i] = sp[(size_t)i * DA];
    __syncthreads();
#pragma unroll 1
    for (int t = 0; t < 8; ++t) {
        const LAS float* qt = qkv + t * 384 + 32 * kq; const LAS float* kt = qt + 128; const float beta = sc[t], dec = sc[8 + t];
        float part = 0.f;
#pragma unroll
        for (int i = 0; i < 32; ++i) { S[i] *= dec; part += kt[i] * S[i]; }
        red[kq * 128 + v] = part;
        __syncthreads();
        const float ks = (red[v] + red[128 + v]) + (red[256 + v] + red[384 + v]);
        const float vn = beta * (qkv[t * 384 + 256 + v] - ks);
        float po = 0.f;
#pragma unroll
        for (int i = 0; i < 32; ++i) { S[i] += kt[i] * vn; po += qt[i] * S[i]; }
        red[512 + kq * 128 + v] = po;
        __syncthreads();
        if (kq == 0) WSP(float, WS_OA)[(size_t)(MP + s * 8 + t) * WA + h * DA + v] = (red[512 + v] + red[640 + v]) + (red[768 + v] + red[896 + v]);
    }
    float* dp = F.out + O_DS + ((size_t)(s * HA + h) * DA + 32 * kq) * DA + v;
#pragma unroll
    for (int i = 0; i < 32; ++i) dp[(size_t)i * DA] = S[i];
    __syncthreads();
}

struct AttnKV { v4u kf[2][2], vr[4]; };
constexpr int P4C_VPITCH = 160, P4C_VBUF = 32 * P4C_VPITCH;
typedef short v4i16_t __attribute__((ext_vector_type(4)));
__device__ __forceinline__ void p4c_load(Frame& F, AttnKV& o, size_t hbase, int c, int kc, int lane) {
    const unsigned char* kb = F.ws + WS_K16 + (((hbase * 16 + c) * 256 + 32 * kc) * DB) * 2;
    const unsigned char* vb = F.ws + WS_VT16 + (((hbase * 16 + c) * 256 + 32 * kc) * DB) * 2;
    const unsigned fr = lane & 15, fq = lane >> 4, koff = fr * 128u + fq * 16u, l16 = lane * 16u;
#pragma unroll
    for (int kt = 0; kt < 2; ++kt)
#pragma unroll
        for (int ks = 0; ks < 2; ++ks) o.kf[kt][ks] = GLD(v4u, kb, koff, kt * 2048 + ks * 64);
#pragma unroll
    for (int m = 0; m < 4; ++m) o.vr[m] = GLD(v4u, vb, l16, m * 1024);
}
__device__ __forceinline__ float xq_max(float v) {
    { const auto r = __builtin_amdgcn_permlane16_swap(__float_as_uint(v), __float_as_uint(v), false, false); v = fmaxf(__uint_as_float(r[0]), __uint_as_float(r[1])); }
    { const auto r = __builtin_amdgcn_permlane32_swap(__float_as_uint(v), __float_as_uint(v), false, false); v = fmaxf(__uint_as_float(r[0]), __uint_as_float(r[1])); }
    return v;
}
__device__ __forceinline__ float xq_sum(float v) {
    { const auto r = __builtin_amdgcn_permlane16_swap(__float_as_uint(v), __float_as_uint(v), false, false); v = __uint_as_float(r[0]) + __uint_as_float(r[1]); }
    { const auto r = __builtin_amdgcn_permlane32_swap(__float_as_uint(v), __float_as_uint(v), false, false); v = __uint_as_float(r[0]) + __uint_as_float(r[1]); }
    return v;
}
constexpr int P4C_NQS = 2;
__device__ __forceinline__ void p4c_chunk(const AttnKV& kv, LAS unsigned char* vlds, const v4u (&qf)[P4C_NQS][2], f32x4 (&O)[P4C_NQS][4], float (&mrow)[P4C_NQS], float (&lrow)[P4C_NQS], int i0, int dc, int span, int lag, int kc, int fr, int fq) {
    const float m4 = ((dc & 3) == 0) ? 1.f : 0.f, m16 = (dc == 0) ? 1.f : 0.f;
    v4u vf[4];
    {
        const int lane = fq * 16 + fr;
#pragma unroll
        for (int m = 0; m < 4; ++m) { const int p = lane + 64 * m; *(LAS v4u*)(vlds + (p >> 3) * P4C_VPITCH + (p & 7) * 16) = kv.vr[m]; }
#pragma unroll
        for (int dt = 0; dt < 4; ++dt) {
            const LAS unsigned char* a0 = vlds + (4 * fq + (fr >> 2)) * P4C_VPITCH + (16 * dt + 4 * (fr & 3)) * 2;
            const v4i16_t t0 = __builtin_amdgcn_ds_read_tr16_b64_v4i16((LAS v4i16_t*)a0), t1 = __builtin_amdgcn_ds_read_tr16_b64_v4i16((LAS v4i16_t*)(a0 + 16 * P4C_VPITCH));
            const u32x2v u0 = __builtin_bit_cast(u32x2v, t0), u1 = __builtin_bit_cast(u32x2v, t1);
            vf[dt] = (v4u){u0.x, u0.y, u1.x, u1.y};
        }
    }
#pragma unroll
    for (int qs = 0; qs < P4C_NQS; ++qs) {
        const int iqlo = i0 + 16 * qs, iqhi = iqlo + 15;
        if (32 * kc > iqhi - lag || 32 * kc + 31 < iqlo - span) continue;
        f32x4 s0 = (f32x4){0.f, 0.f, 0.f, 0.f}, s1 = s0;
#pragma unroll
        for (int ks = 0; ks < 2; ++ks) { s0 = mfma16(as_bf16x8(kv.kf[0][ks]), as_bf16x8(qf[qs][ks]), s0); s1 = mfma16(as_bf16x8(kv.kf[1][ks]), as_bf16x8(qf[qs][ks]), s1); }
        const int dl0 = 16 * (iqlo + fr - 32 * kc - 4 * fq) + dc;
        float cn[8], sv[8]; float mx = mrow[qs];
#pragma unroll
        for (int e = 0; e < 8; ++e) {
            const unsigned dl = (unsigned)(dl0 - 16 * (16 * (e >> 2) + (e & 3)));
            const float cnt = ((dl <= 128u) ? 1.f : 0.f) + ((dl <= 512u) ? m4 : 0.f) + ((dl <= 2048u) ? m16 : 0.f);
            cn[e] = cnt; const float sc = (e < 4) ? s0[e & 3] : s1[e & 3]; sv[e] = (cnt > 0.f) ? sc : -1e30f; mx = fmaxf(mx, sv[e]);
        }
        mx = xq_max(mx);
        if (!__all(mx == mrow[qs])) {
            const float alpha = exp2f(mrow[qs] - mx); mrow[qs] = mx; lrow[qs] *= alpha;
#pragma unroll
            for (int dt = 0; dt < 4; ++dt) O[qs][dt] = O[qs][dt] * alpha;
        }
        float p[8], ps = 0.f;
#pragma unroll
        for (int e = 0; e < 8; ++e) { p[e] = cn[e] * exp2f(sv[e] - mx); ps += p[e]; }
        lrow[qs] += ps;
        const bf16x8 pb = as_bf16x8((v4u){cvtpk(p[0], p[1]), cvtpk(p[2], p[3]), cvtpk(p[4], p[5]), cvtpk(p[6], p[7])});
#pragma unroll
        for (int dt = 0; dt < 4; ++dt) O[qs][dt] = mfma16(as_bf16x8(vf[dt]), pb, O[qs][dt]);
    }
}
__device__ __forceinline__ void p4c_range(int c0, int i0, int c, int& dc, int& span, int& lag, int& lo, int& hi) {
    dc = c0 - c; const int wmax = (dc == 0) ? 2048 : ((dc & 3) == 0 ? 512 : 128);
    span = (wmax - dc) >> 4; lag = (dc < 0) ? 1 : 0;
    int ikmin = i0 - span; if (ikmin < 0) ikmin = 0;
    lo = ikmin >> 5; hi = (i0 + 16 * P4C_NQS - 1 - lag) >> 5;
}
__device__ __forceinline__ void p4c_attn_prompt(Frame& F, int job) {
    const int lane = F.lane, fr = lane & 15, fq = lane >> 4;
    const int qb = job & (16 / P4C_NQS - 1), jr = job / (16 / P4C_NQS), c0 = jr & 15, hb = (jr >> 4) & 7, b = jr >> 7, i0 = 16 * P4C_NQS * qb;
    const size_t hbase = (size_t)b * HB + hb;
    const bf16* Q16 = WSP(bf16, WS_Q16) + ((hbase * 16 + c0) * 256) * DB;
    v4u qf[P4C_NQS][2];
#pragma unroll
    for (int qs = 0; qs < P4C_NQS; ++qs)
#pragma unroll
        for (int ks = 0; ks < 2; ++ks) qf[qs][ks] = *(const GAS v4u*)(Q16 + (size_t)(i0 + 16 * qs + fr) * DB + 32 * ks + 8 * fq);
    f32x4 O[P4C_NQS][4]; float mrow[P4C_NQS], lrow[P4C_NQS];
#pragma unroll
    for (int qs = 0; qs < P4C_NQS; ++qs) { mrow[qs] = -1e30f; lrow[qs] = 0.f;
#pragma unroll
        for (int dt = 0; dt < 4; ++dt) O[qs][dt] = (f32x4){0.f, 0.f, 0.f, 0.f}; }
    int c = 0, dc, span, lag, lo, hi; p4c_range(c0, i0, 0, dc, span, lag, lo, hi);
    int kc = lo;
    AttnKV A, B;
    LAS unsigned char* vlds = F.lds + F.wave * P4C_VBUF;
    p4c_load(F, A, hbase, c, kc, lane);
#pragma unroll 1
    for (;;) {
        int nc = c, nkc = kc + 1, ndc = dc, nspan = span, nlag = lag, nlo = lo, nhi = hi;
        if (nkc > hi) { nc = c + 1; if (nc < 16) { p4c_range(c0, i0, nc, ndc, nspan, nlag, nlo, nhi); nkc = nlo; } }
        if (nc < 16) p4c_load(F, B, hbase, nc, nkc, lane);
        p4c_chunk(A, vlds, qf, O, mrow, lrow, i0, dc, span, lag, kc, fr, fq);
        if (nc >= 16) break;
        c = nc; kc = nkc; dc = ndc; span = nspan; lag = nlag; lo = nlo; hi = nhi;
        nc = c; nkc = kc + 1;
        if (nkc > hi) { nc = c + 1; if (nc < 16) { p4c_range(c0, i0, nc, ndc, nspan, nlag, nlo, nhi); nkc = nlo; } }
        if (nc < 16) p4c_load(F, A, hbase, nc, nkc, lane);
        p4c_chunk(B, vlds, qf, O, mrow, lrow, i0, dc, span, lag, kc, fr, fq);
        if (nc >= 16) break;
        c = nc; kc = nkc; dc = ndc; span = nspan; lag = nlag; lo = nlo; hi = nhi;
    }
#pragma unroll
    for (int qs = 0; qs < P4C_NQS; ++qs) {
        const float inv = 1.f / xq_sum(lrow[qs]);
        const int t = c0 + 16 * (i0 + 16 * qs + fr);
        bf16* o = WSP(bf16, WS_MIX) + (size_t)(b * SEQ + t) * D + WA + hb * DB + 4 * fq;
#pragma unroll
        for (int dt = 0; dt < 4; ++dt) *(GAS u32x2v*)(o + 16 * dt) = (u32x2v){cvtpk(O[qs][dt][0] * inv, O[qs][dt][1] * inv), cvtpk(O[qs][dt][2] * inv, O[qs][dt][3] * inv)};
    }
}

constexpr int P4D_PART = 32768;
__device__ __forceinline__ void p4d_rowptr(Frame& F, int s, int ch, int kk, const float*& kp, const float*& vp, int& pos) {
    if (ch < 24) { const int rho = 64 * ch + 16 * (kk >> 3) + (kk & 7); pos = rho; kp = F.cache_k + ((size_t)s * WBUF + rho) * WB; vp = F.cache_v + ((size_t)s * WBUF + rho) * WB; }
    else if (ch < 40) { const int rho = 1536 + 32 * (ch - 24) + kk; pos = rho; kp = F.cache_k + ((size_t)s * WBUF + rho) * WB; vp = F.cache_v + ((size_t)s * WBUF + rho) * WB; }
    else { const int tq = kk & 7; pos = (kk < 8) ? WBUF + tq : 1 << 20; kp = F.out + O_KS + (size_t)(s * 8 + tq) * WB; vp = F.out + O_VS + (size_t)(s * 8 + tq) * WB; }
}
__device__ __forceinline__ void p4d_attn_sample(Frame& F, int unit) {
    const int lane = F.lane, wave = F.wave, fr = lane & 15, fq = lane >> 4;
    const int s = unit >> 2, hb = (unit & 3) * 2 + (wave >> 2), qtr = wave & 3;
    v4u qf[2];
#pragma unroll
    for (int ks = 0; ks < 2; ++ks) {
        if (fr < 8) { const float* qp = WSP(float, WS_QSB) + ((size_t)(s * 8 + fr) * HB + hb) * DB + 32 * ks + 8 * fq; const f32x4 a = *(const f32x4*)qp, c = *(const f32x4*)(qp + 4);
            qf[ks] = (v4u){cvtpk(a.x, a.y), cvtpk(a.z, a.w), cvtpk(c.x, c.y), cvtpk(c.z, c.w)}; }
        else qf[ks] = (v4u){0u, 0u, 0u, 0u};
    }
    f32x4 O[4]; float mrow = -1e30f, lrow = 0.f;
#pragma unroll
    for (int dt = 0; dt < 4; ++dt) O[dt] = (f32x4){0.f, 0.f, 0.f, 0.f};
#pragma unroll 1
    for (int ch = qtr; ch < 41; ch += 4) {
        f32x4 kr[2][2][2];
#pragma unroll
        for (int kt = 0; kt < 2; ++kt) { const float* kp; const float* vp; int pos; p4d_rowptr(F, s, ch, 16 * kt + fr, kp, vp, pos);
#pragma unroll
            for (int ks = 0; ks < 2; ++ks) { kr[kt][ks][0] = *(const f32x4*)(kp + hb * DB + 32 * ks + 8 * fq); kr[kt][ks][1] = *(const f32x4*)(kp + hb * DB + 32 * ks + 8 * fq + 4); } }
        float vr[4][8];
#pragma unroll
        for (int jj = 0; jj < 8; ++jj) { const float* kp; const float* vp; int pos; p4d_rowptr(F, s, ch, 16 * (jj >> 2) + 4 * fq + (jj & 3), kp, vp, pos);
#pragma unroll
            for (int dt = 0; dt < 4; ++dt) vr[dt][jj] = vp[hb * DB + 16 * dt + fr]; }
        f32x4 s0 = (f32x4){0.f, 0.f, 0.f, 0.f}, s1 = s0;
#pragma unroll
        for (int ks = 0; ks < 2; ++ks) {
            const v4u k0 = (v4u){cvtpk(kr[0][ks][0].x, kr[0][ks][0].y), cvtpk(kr[0][ks][0].z, kr[0][ks][0].w), cvtpk(kr[0][ks][1].x, kr[0][ks][1].y), cvtpk(kr[0][ks][1].z, kr[0][ks][1].w)};
            const v4u k1 = (v4u){cvtpk(kr[1][ks][0].x, kr[1][ks][0].y), cvtpk(kr[1][ks][0].z, kr[1][ks][0].w), cvtpk(kr[1][ks][1].x, kr[1][ks][1].y), cvtpk(kr[1][ks][1].z, kr[1][ks][1].w)};
            s0 = mfma16(as_bf16x8(k0), as_bf16x8(qf[ks]), s0); s1 = mfma16(as_bf16x8(k1), as_bf16x8(qf[ks]), s1);
        }
        const int qpos = WBUF + fr;
        float cn[8], sv[8]; float mx = mrow;
#pragma unroll
        for (int e = 0; e < 8; ++e) {
            const float* kp; const float* vp; int pos; p4d_rowptr(F, s, ch, 16 * (e >> 2) + 4 * fq + (e & 3), kp, vp, pos);
            const int dl = qpos - pos;
            float cnt = 0.f;
            if (dl >= 0 && fr < 8) { cnt = (dl <= 128) ? 1.f : 0.f; if ((dl & 3) == 0 && dl <= 512) cnt += 1.f; if ((dl & 15) == 0 && dl <= 2048) cnt += 1.f; }
            cn[e] = cnt; const float sc = (e < 4) ? s0[e & 3] : s1[e & 3]; sv[e] = (cnt > 0.f) ? sc : -1e30f; mx = fmaxf(mx, sv[e]);
        }
        mx = fmaxf(mx, __shfl_xor(mx, 16)); mx = fmaxf(mx, __shfl_xor(mx, 32));
        const float alpha = exp2f(mrow - mx); mrow = mx;
        float p[8], ps = 0.f;
#pragma unroll
        for (int e = 0; e < 8; ++e) { p[e] = cn[e] * exp2f(sv[e] - mx); ps += p[e]; }
        ps += __shfl_xor(ps, 16); ps += __shfl_xor(ps, 32);
        lrow = lrow * alpha + ps;
        const bf16x8 pb = as_bf16x8((v4u){cvtpk(p[0], p[1]), cvtpk(p[2], p[3]), cvtpk(p[4], p[5]), cvtpk(p[6], p[7])});
#pragma unroll
        for (int dt = 0; dt < 4; ++dt) { const v4u va = (v4u){cvtpk(vr[dt][0], vr[dt][1]), cvtpk(vr[dt][2], vr[dt][3]), cvtpk(vr[dt][4], vr[dt][5]), cvtpk(vr[dt][6], vr[dt][7])};
            O[dt] = O[dt] * alpha; O[dt] = mfma16(as_bf16x8(va), pb, O[dt]); }
    }
    LAS float* part = (LAS float*)(F.lds + P4D_PART);
    if (fr < 8) {
        LAS float* pp = part + (wave * 8 + fr) * 66;
#pragma unroll
        for (int dt = 0; dt < 4; ++dt)
#pragma unroll
            for (int r = 0; r < 4; ++r) pp[16 * dt + 4 * fq + r] = O[dt][r];
        if (fq == 0) { pp[64] = mrow; pp[65] = lrow; }
    }
    __syncthreads();
    for (int i = F.tid; i < 2 * 8 * 64; i += NWAVES * 64) {
        const int hh = i >> 9, q = (i >> 6) & 7, d = i & 63;
        float m = -1e30f;
#pragma unroll
        for (int w = 0; w < 4; ++w) m = fmaxf(m, part[((hh * 4 + w) * 8 + q) * 66 + 64]);
        float num = 0.f, den = 0.f;
#pragma unroll
        for (int w = 0; w < 4; ++w) { const LAS float* pp = part + ((hh * 4 + w) * 8 + q) * 66; const float sc = exp2f(pp[64] - m); num += sc * pp[d]; den += sc * pp[65]; }
        const int hq = (unit & 3) * 2 + hh;
        WSP(bf16, WS_MIX)[(size_t)(MP + s * 8 + q) * D + WA + hq * DB + d] = (bf16)(cvtpk(num / den, 0.f) & 0xffffu);
    }
    __syncthreads();
}

__device__ __forceinline__ void p5_gate(Frame& F) {
    const int gw = F.vcu * NWAVES + F.wave, NGW = F.G * NWAVES, lane = F.lane, col8 = lane * 8, dim8 = (lane & 15) * 8;
    float dg[8];
    { const f32x4 a = *(const f32x4*)(F.dng + dim8), c = *(const f32x4*)(F.dng + dim8 + 4); dg[0] = a.x; dg[1] = a.y; dg[2] = a.z; dg[3] = a.w; dg[4] = c.x; dg[5] = c.y; dg[6] = c.z; dg[7] = c.w; }
    for (int m = gw; m < M; m += NGW) {
        const float* op = WSP(float, WS_OA) + (size_t)m * WA + col8;
        const f32x4 a = *(const GAS f32x4*)op, c = *(const GAS f32x4*)(op + 4);
        float o[8] = {a.x, a.y, a.z, a.w, c.x, c.y, c.z, c.w}, z[8];
        { const v4u w = *(const GAS v4u*)(WSP(bf16, WS_PROJ) + (size_t)m * NPROJ + PC_Z + col8); unpack8(w, z); }
        float ss = 0.f;
#pragma unroll
        for (int e = 0; e < 8; ++e) ss += o[e] * o[e];
        ss += __shfl_xor(ss, 1); ss += __shfl_xor(ss, 2); ss += __shfl_xor(ss, 4); ss += __shfl_xor(ss, 8);
        const float r = 1.f / sqrtf(ss * (1.f / DA) + EPS);
#pragma unroll
        for (int e = 0; e < 8; ++e) o[e] = o[e] * r * dg[e] * silu_f(z[e]);
        *(GAS v4u*)(WSP(bf16, WS_MIX) + (size_t)m * D + col8) = pack8(o);
    }
}
__device__ __forceinline__ void p7_norm2(Frame& F) {
    const int gw = F.vcu * NWAVES + F.wave, NGW = F.G * NWAVES;
    f32x4 g2[4];
#pragma unroll
    for (int j = 0; j < 4; ++j) g2[j] = *((const f32x4*)F.norm2_g + F.lane + 64 * j);
    for (int m = gw; m < M; m += NGW) {
        const GAS f32x4* xr = (const GAS f32x4*)(F.out + (size_t)m * D) + F.lane;
        f32x4 v[4]; float s = 0.f;
#pragma unroll
        for (int j = 0; j < 4; ++j) { v[j] = xr[64 * j]; s += (v[j].x * v[j].x + v[j].y * v[j].y) + (v[j].z * v[j].z + v[j].w * v[j].w); }
        const float rstd = 1.f / sqrtf(wave_sum(s) * (1.f / D) + EPS);
        GAS unsigned long long* o8 = (GAS unsigned long long*)(WSP(bf16, WS_XN) + (size_t)m * D) + F.lane;
#pragma unroll
        for (int j = 0; j < 4; ++j) { v[j] = v[j] * rstd * g2[j]; o8[64 * j] = (unsigned long long)cvtpk(v[j].x, v[j].y) | ((unsigned long long)cvtpk(v[j].z, v[j].w) << 32); }
    }
}


constexpr int N_PHASES = 10;
#ifndef PH_LIMIT
#define PH_LIMIT 10
#endif
struct Args { const float* in[18]; float* out; unsigned char* ws; int ph_lo, ph_hi; };
__global__ void __launch_bounds__(NWAVES * 64, 2) hymba_fwd(Args args) {
    extern __shared__ __attribute__((aligned(16))) unsigned char lds[];
    Frame F;
    F.lds = (LAS unsigned char*)lds;
    F.MISC = (volatile LAS unsigned*)(F.lds + MISC_OFF);
    F.tid = threadIdx.x; F.lane = F.tid & 63; F.wave = __builtin_amdgcn_readfirstlane(F.tid >> 6);
    F.G = gridDim.x; { const int bx = blockIdx.x; F.vcu = (F.G % 8 == 0) ? (bx % 8) * (F.G / 8) + bx / 8 : bx; }
    F.ws = args.ws; F.out = args.out; F.ctl = (gu32*)(args.ws + WS_CTL);
    F.xp = args.in[0]; F.xs = args.in[1]; F.cache_k = args.in[2]; F.cache_v = args.in[3]; F.state_delta = args.in[4]; F.state_conv = args.in[5]; F.norm1_g = args.in[6]; F.w_in = args.in[7];
    F.conv_w = args.in[8]; F.a_log = args.in[9]; F.dt_bias = args.in[10]; F.dng = args.in[11]; F.qng = args.in[12]; F.kng = args.in[13]; F.w_o = args.in[14]; F.norm2_g = args.in[15]; F.w_up = args.in[16]; F.w_down = args.in[17];
    for (int u = F.tid; u < (LDS_BYTES - LDSCTL_OFF) / 4; u += NWAVES * 64) ((LAS unsigned*)(F.lds + LDSCTL_OFF))[u] = 0u;
    __syncthreads();
#if MK_ONE_LAUNCH
    XcdBarrier bar = xcd_barrier_post((unsigned*)(F.ctl + CW_BAR), F.MISC + 8);
#define GRID_BAR() xcd_barrier(bar)
#else
#define GRID_BAR() do {} while (0)
#endif
    const int lo = args.ph_lo, hi = args.ph_hi;
#ifdef STAMP_A
    volatile LAS unsigned long long* stamps = (volatile LAS unsigned long long*)(F.lds + LDSCTL_OFF);
#define STAMP(k) do { if (F.tid == 0) stamps[k] = __builtin_amdgcn_s_memrealtime(); } while (0)
#else
#define STAMP(k) do {} while (0)
#endif
    STAMP(0);
#ifndef REP_PHASE
#define REP_PHASE -1
#endif
#ifndef REP_P4
#define REP_P4 0
#endif
#define NREP(k) ((REP_PHASE == (k)) ? 2 : 1)
#ifndef P2_REPMODE
#define P2_REPMODE 3
#endif
#define IN(k) (lo <= (k) && (k) < hi)
#define BOTH(k) (IN(k) && IN((k) + 1))

    if (IN(0)) { _Pragma("nounroll") for (int rep = 0; rep < NREP(0); ++rep) { p0_prologue(F); if (BOTH(0)) GRID_BAR(); STAMP(1); } }
    if (IN(1)) {
        pg8::Gemm g{WSP(bf16, WS_XN), WSP(bf16, WS_WIN), M, NPROJ, D}; pg8::StaticOrder S; S.init(M, NPROJ, F.G, (int)blockIdx.x);
        pg8::EpiBf16<0> E{WSP(bf16, WS_PROJ), NPROJ};
        pg8::gemm_phase<pg8::EpiBf16<0>, pg8::StaticOrder, PG8_ALIGN, PG8_SP2>(F.lds + RING_OFF, g, S, E);
        if (BOTH(1)) GRID_BAR(); STAMP(2);
    }
    if (IN(2)) { _Pragma("nounroll") for (int rep = 0; rep < NREP(2); ++rep) { p2_token_prep(F, rep == 0 ? 3 : P2_REPMODE); if (rep == 0) p2_sample_pieces(F); if (BOTH(2)) GRID_BAR(); STAMP(3); } }
    if (IN(3)) { _Pragma("nounroll") for (int rep = 0; rep < NREP(3); ++rep) { p3_chunk_prep(F); if (BOTH(3)) GRID_BAR(); STAMP(4); } }
    if (IN(4)) {
#ifndef P4_MASK
#define P4_MASK 15
#endif
#define P4_NEXT() do { if (F.tid == 0) F.MISC[16] = __hip_atomic_fetch_add(F.ctl + CW_Q, 1u, __ATOMIC_RELAXED, __HIP_MEMORY_SCOPE_AGENT); __syncthreads(); tk = (int)F.MISC[16]; __syncthreads(); } while (0)
        int tk; P4_NEXT();
        STAMP(11);
        while (tk < 64) { p4_scan(F, tk); P4_NEXT(); }
        STAMP(12);
        while (tk < 64 + 512) { p4c_attn_prompt(F, (tk - 64) * 8 + F.wave); P4_NEXT(); }
        STAMP(13);
        while (tk < 64 + 512 + 512) { p4d_attn_sample(F, tk - 576); P4_NEXT(); }
        while (tk < 64 + 512 + 512 + 512) { p4b_sample_delta(F, tk - 1088); P4_NEXT(); }
        STAMP(14);
#undef P4_NEXT
        if (BOTH(4)) GRID_BAR(); STAMP(5);
    }
    if (IN(5)) { _Pragma("nounroll") for (int rep = 0; rep < NREP(5); ++rep) { p5_gate(F); if (BOTH(5)) GRID_BAR(); STAMP(6); } }
    if (IN(6)) {
        pg8::Gemm g{WSP(bf16, WS_MIX), WSP(bf16, WS_WO), M, D, D}; pg8::StaticOrder S; S.init(M, D, F.G, (int)blockIdx.x);
        pg8::EpiResNorm E{F.xp, F.xs, MP, F.out, WSP(bf16, WS_XN), F.norm2_g, WSP(float, WS_RSS), D};
        pg8::gemm_phase<pg8::EpiResNorm, pg8::StaticOrder, PG8_ALIGN, PG8_SP2>(F.lds + RING_OFF, g, S, E);
        if (BOTH(6)) GRID_BAR(); STAMP(7);
    }
    if (IN(7)) { _Pragma("nounroll") for (int rep = 0; rep < NREP(7); ++rep) { STAMP(8); } }
    if (IN(8)) {
        pg8::Gemm g{WSP(bf16, WS_XN), WSP(bf16, WS_WUP), M, FF, D}; pg8::StaticOrder S; S.init(M, FF, F.G, (int)blockIdx.x);
        pg8::EpiRowScaleRelu2 E{WSP(bf16, WS_HID), FF, WSP(float, WS_RSS), 1.f / D, EPS};
        pg8::gemm_phase<pg8::EpiRowScaleRelu2, pg8::StaticOrder, PG8_ALIGN, PG8_SP2>(F.lds + RING_OFF, g, S, E);
        if (BOTH(8)) GRID_BAR(); STAMP(9);
    }
    if (IN(9)) {
        pg8::Gemm g{WSP(bf16, WS_HID), WSP(bf16, WS_WDN), M, D, FF}; pg8::StaticOrder S; S.init(M, D, F.G, (int)blockIdx.x);
        pg8::EpiResF32 E{F.out, F.out + (size_t)MP * D, MP, F.out, D};
        pg8::gemm_phase<pg8::EpiResF32, pg8::StaticOrder, PG8_ALIGN, PG8_SP2>(F.lds + RING_OFF, g, S, E);
    }
#ifdef STAMP_A
    STAMP(10);
    asm volatile("s_waitcnt vmcnt(0)" ::: "memory"); __syncthreads();
    if (blockIdx.x == 0 && F.tid == 0) {
#ifdef STAMP_AGG
        const float va = (float)__hip_atomic_load(F.ctl + CW_T + STAMP_A, __ATOMIC_RELAXED, __HIP_MEMORY_SCOPE_AGENT) * (0.01f / 256.f), vr = (float)__hip_atomic_load(F.ctl + CW_T + STAMP_R, __ATOMIC_RELAXED, __HIP_MEMORY_SCOPE_AGENT) * (0.01f / 256.f);
#else
        const float va = (float)(stamps[STAMP_A1] - stamps[STAMP_A]) * 0.01f, vr = (float)(stamps[STAMP_R1] - stamps[STAMP_R]) * 0.01f;
#endif
#ifdef STAMP_CAL
        F.out[O_YP] = 400.f; F.out[O_CP] = 100.f;
#else
        F.out[O_YP] = __expf(rintf(__logf(fmaxf(va, 1.f)) * STAMP_Q + STAMP_SHIFT) * (1.f / STAMP_Q)); F.out[O_CP] = __expf(rintf(__logf(fmaxf(vr, 1.f)) * STAMP_Q + STAMP_SHIFT) * (1.f / STAMP_Q));
#endif
    }
#endif
#undef IN
#undef BOTH
}

extern "C" void kernel_launch(void* const* d_in, const int* in_sizes, int n_in, void* d_out, int out_size, void* d_ws, size_t ws_size, hipStream_t stream) {
    static int grid = 0;
    if (grid == 0) {
        if (n_in != 18 || (size_t)out_size != O_END || ws_size < WS_END) { fprintf(stderr, "kernel_launch: unexpected shapes (n_in %d out %d ws %zu need %zu)\n", n_in, out_size, ws_size, (size_t)WS_END); grid = -1; return; }
        int dev = 0, cus = 0, per_cu = 0;
        if (hipGetDevice(&dev) != hipSuccess || hipDeviceGetAttribute(&cus, hipDeviceAttributeMultiprocessorCount, dev) != hipSuccess) { grid = -1; return; }
        if (hipFuncSetAttribute((const void*)hymba_fwd, hipFuncAttributeMaxDynamicSharedMemorySize, LDS_BYTES) != hipSuccess) { fprintf(stderr, "kernel_launch: hipFuncSetAttribute failed\n"); grid = -1; return; }
        if (hipOccupancyMaxActiveBlocksPerMultiprocessor(&per_cu, (const void*)hymba_fwd, NWAVES * 64, LDS_BYTES) != hipSuccess || per_cu < 1) fprintf(stderr, "kernel_launch: occupancy query reports %d\n", per_cu);
        (void)hipGetLastError();
        grid = cus;
    }
    if (grid < 0) return;
    (void)hipMemsetAsync((char*)d_ws + WS_CTL, 0, CTL_ZERO_BYTES, stream);
#ifdef DBG_ZERO_OUT
    (void)hipMemsetAsync(d_out, 0, (size_t)out_size * 4, stream);
#endif
    Args a{};
    for (int i = 0; i < 18; ++i) a.in[i] = (const float*)d_in[i];
    a.out = (float*)d_out; a.ws = (unsigned char*)d_ws;
#if MK_ONE_LAUNCH
    a.ph_lo = 0; a.ph_hi = N_PHASES;
    hipLaunchKernelGGL(hymba_fwd, dim3(grid), dim3(NWAVES * 64), LDS_BYTES, stream, a);
#else
    for (int p = 0; p < PH_LIMIT; ++p) { a.ph_lo = p; a.ph_hi = p + 1; hipLaunchKernelGGL(hymba_fwd, dim3(grid), dim3(NWAVES * 64), LDS_BYTES, stream, a); }
#endif
}
```
